# Optimizing an MI355X kernel written in HIP

```python
import numpy as np
import jax
import jax.numpy as jnp
from jax import lax

D_MODEL = 1024
BATCH = 16
SEQ = 2048
DEPTH = 1

GRID_W = 64
CTX_LEN = 256

RET_HEAD_DIM = 128
RET_WIDTH = D_MODEL // 2
RET_HEADS = RET_WIDTH // RET_HEAD_DIM
RET_CHUNK = 128
RET_EPS = 1e-5
ROPE_BASE = 10000.0

RWKV_HEAD_DIM = 64
RWKV_WIDTH = D_MODEL // 2
RWKV_HEADS = RWKV_WIDTH // RWKV_HEAD_DIM
DECAY_LORA = 64
ICLR_LORA = 64
GATE_LORA = 128
RWKV_EPS = 64e-5

N_EXPERTS = 16
EXPERT_FF = 1024
CAPACITY_FACTOR = 2

N_MOD = 6
NORM_EPS = 1e-6

STATE_SIZES = (RET_WIDTH, RET_WIDTH, RWKV_WIDTH, RWKV_WIDTH, DECAY_LORA, ICLR_LORA)
QUERY_SIZES = (RET_WIDTH, RET_WIDTH, RWKV_WIDTH, GATE_LORA, 2 * D_MODEL)
STATE_COLS = sum(STATE_SIZES)
IN_COLS = STATE_COLS + sum(QUERY_SIZES)
SHIFT_STATE_COLS = 2 * RWKV_WIDTH + DECAY_LORA + ICLR_LORA
SHIFT_QUERY_COLS = RWKV_WIDTH + GATE_LORA
SHIFT_COLS = SHIFT_STATE_COLS + SHIFT_QUERY_COLS

kernel_name = 'hybrid_retention_rwkv7_ecmoe_dit_layer'


def _split(z, sizes):
    offs = np.cumsum((0,) + tuple(sizes))
    return [z[..., int(offs[i]):int(offs[i + 1])] for i in range(len(sizes))]


def _ident(a):
    return a


def _flip(a):
    return a[:, ::-1]


def _heads(a, dim):
    return a.reshape(a.shape[:-1] + (a.shape[-1] // dim, dim))


def _rmsnorm(x, g):
    xf = x.astype(jnp.float32)
    y = xf * lax.rsqrt(jnp.mean(xf * xf, axis=-1, keepdims=True) + NORM_EPS)
    return (y * g.astype(jnp.float32)).astype(x.dtype)


def _head_norm(x, eps):
    xf = x.astype(jnp.float32)
    mu = jnp.mean(xf, axis=-1, keepdims=True)
    var = jnp.mean(jnp.square(xf - mu), axis=-1, keepdims=True)
    y = (xf - mu) * lax.rsqrt(var + eps)
    return y.reshape(y.shape[:-2] + (-1,))


def _rope_2d(x):
    n = x.shape[1]
    t = jnp.arange(n)
    half = x.shape[-1] // 2
    nfreq = half // 2
    inv = ROPE_BASE ** (-jnp.arange(nfreq, dtype=jnp.float32) / nfreq)
    ang = jnp.concatenate([(t // GRID_W).astype(jnp.float32)[:, None] * inv,
                           (t % GRID_W).astype(jnp.float32)[:, None] * inv], axis=-1)
    cos = jnp.cos(ang)[None, :, None, :].astype(x.dtype)
    sin = jnp.sin(ang)[None, :, None, :].astype(x.dtype)
    x1, x2 = x[..., :half], x[..., half:]
    return jnp.concatenate([x1 * cos - x2 * sin, x1 * sin + x2 * cos], axis=-1)


def _centred_shift(p, mu):
    prev = jnp.pad(p[:, :-1], ((0, 0), (1, 0), (0, 0)))
    nxt = jnp.pad(p[:, 1:], ((0, 0), (0, 1), (0, 0)))
    return p + mu[0] * (prev - p) + mu[1] * (nxt - p)


def _retention_chunkwise(q, k, v, log_gamma, r0):
    b, t, h, _ = q.shape
    dv = v.shape[-1]
    n_chunks = t // RET_CHUNK
    lg = log_gamma.astype(jnp.float32)
    pos = jnp.arange(RET_CHUNK, dtype=jnp.float32)
    diff = pos[:, None] - pos[None, :]
    intra = jnp.where(diff >= 0, jnp.exp(lg[:, None, None] * jnp.maximum(diff, 0.0)), 0.0)
    cross = jnp.exp(lg[None, :] * (pos[:, None] + 1.0))
    tail = jnp.exp(lg[None, :] * (RET_CHUNK - 1.0 - pos[:, None]))
    chunk_decay = jnp.exp(lg * RET_CHUNK)

    def to_chunks(a):
        a = a.astype(jnp.float32).reshape(b, n_chunks, RET_CHUNK, h, a.shape[-1])
        return jnp.moveaxis(a, 1, 0)

    def step(r, xs):
        qc, kc, vc = xs
        s = jnp.einsum('bihd,bjhd->bhij', qc, kc) * intra
        o = (jnp.einsum('bhij,bjhe->bihe', s, vc)
             + jnp.einsum('bihd,bhde->bihe', qc, r) * cross[None, :, :, None])
        r = r * chunk_decay[None, :, None, None] + jnp.einsum('bjhd,bjhe->bhde', kc * tail[None, :, :, None], vc)
        return r, o

    r_final, o = lax.scan(step, r0.astype(jnp.float32), (to_chunks(q), to_chunks(k), to_chunks(v)))
    o = jnp.moveaxis(o, 0, 1).reshape(b, t, h, dv)
    return o.astype(v.dtype), r_final


def _retention_final_state(k, v, log_gamma):
    t = k.shape[1]
    w = jnp.exp(log_gamma[None, :] * (t - 1.0 - jnp.arange(t, dtype=jnp.float32)[:, None]))
    return jnp.einsum('bjhd,bjhe->bhde', k.astype(jnp.float32) * w[None, :, :, None], v.astype(jnp.float32))


def _rwkv7_scan(s0, w, k, v, kk, a, r=None):
    seq = [w, k, v, kk, a] + ([] if r is None else [r])
    xs = tuple(jnp.moveaxis(t.astype(jnp.float32), 1, 0) for t in seq)

    def step(s, xt):
        wt, kt, vt, kkt, at = xt[:5]
        sa = jnp.einsum('bhvk,bhk->bhv', s, -kkt)
        s = (s * wt[:, :, None, :] + sa[..., None] * (kkt * at)[:, :, None, :]
             + vt[..., None] * kt[:, :, None, :])
        if r is None:
            return s, None
        return s, jnp.einsum('bhvk,bhk->bhv', s, xt[5])

    s, ys = lax.scan(step, s0, xs)
    if r is None:
        return s, None
    return s, jnp.moveaxis(ys, 0, 1).astype(v.dtype)


def _side_state(h, lp, latent):
    z = h @ lp['w_in'][:, :STATE_COLS]
    ret_k, ret_v = _split(z[..., :2 * RET_WIDTH], (RET_WIDTH, RET_WIDTH))
    zr = _centred_shift(z[..., 2 * RET_WIDTH:], lp['rwkv_mu'][:, :SHIFT_STATE_COLS])
    k, v, wd, ad = _split(zr, (RWKV_WIDTH, RWKV_WIDTH, DECAY_LORA, ICLR_LORA))
    ret_k = _heads(ret_k, RET_HEAD_DIM) * (RET_HEAD_DIM ** -0.5)
    if latent:
        ret_k = _rope_2d(ret_k)
    kk = _heads(k * lp['rwkv_k_k'], RWKV_HEAD_DIM).astype(jnp.float32)
    kk = kk * lax.rsqrt(jnp.sum(kk * kk, axis=-1, keepdims=True) + 1e-12)
    u = lp['rwkv_w0'][:, None, None, :] + jnp.einsum('btr,drc->dbtc', jnp.tanh(wd), lp['rwkv_w2'])
    w = jnp.exp(-jnp.exp(-jax.nn.softplus(-u.astype(jnp.float32)) - 0.5))
    a = jax.nn.sigmoid(lp['rwkv_a0'][:, None, None, :] + jnp.einsum('btr,drc->dbtc', ad, lp['rwkv_a2']))
    k_dir = k[None] * (1.0 + (a - 1.0) * lp['rwkv_k_a'])
    return {'ret_k': ret_k, 'ret_v': _heads(ret_v, RET_HEAD_DIM), 'kk': kk,
            'w': _heads(w, RWKV_HEAD_DIM), 'a': _heads(a, RWKV_HEAD_DIM),
            'k': _heads(k_dir, RWKV_HEAD_DIM), 'v': _heads(v, RWKV_HEAD_DIM)}


def _side_query(h, lp, latent):
    z = h @ lp['w_in'][:, STATE_COLS:]
    ret_q, ret_g = _split(z[..., :2 * RET_WIDTH], (RET_WIDTH, RET_WIDTH))
    zr = _centred_shift(z[..., 2 * RET_WIDTH:2 * RET_WIDTH + SHIFT_QUERY_COLS], lp['rwkv_mu'][:, SHIFT_STATE_COLS:])
    r, gd = _split(zr, (RWKV_WIDTH, GATE_LORA))
    merge = z[..., 2 * RET_WIDTH + SHIFT_QUERY_COLS:]
    ret_q = _heads(ret_q, RET_HEAD_DIM)
    if latent:
        ret_q = _rope_2d(ret_q)
    return {'ret_q': ret_q, 'ret_g': ret_g, 'r': _heads(r, RWKV_HEAD_DIM),
            'rwkv_g': jax.nn.sigmoid(gd) @ lp['rwkv_g2'], 'merge': jax.nn.sigmoid(merge)}


def _branch_merge(ret_o, rwkv_o, st, qu, lp):
    dt = qu['ret_g'].dtype
    y_ret = (jax.nn.silu(qu['ret_g']) * (_head_norm(ret_o, RET_EPS) * lp['ret_gn_g']).astype(dt)) @ lp['w_br_ret']
    r_k = lp['rwkv_r_k'].reshape(RWKV_HEADS, RWKV_HEAD_DIM)
    bonus = jnp.sum(qu['r'][None] * st['k'] * r_k, axis=-1, keepdims=True).sum(0) * st['v']
    y_rw = (_head_norm(rwkv_o, RWKV_EPS) * lp['rwkv_ln_g'] + lp['rwkv_ln_b']).astype(dt)
    y_rw = ((y_rw + bonus.reshape(bonus.shape[:-2] + (-1,))) * qu['rwkv_g']) @ lp['w_br_rwkv']
    g_ret, g_rw = jnp.split(qu['merge'], 2, axis=-1)
    return (g_ret * y_ret + g_rw * y_rw) @ lp['w_out']


def _token_mixer(h_lat, h_ctx, lp, ctx_out):
    st_l = _side_state(h_lat, lp, True)
    qu_l = _side_query(h_lat, lp, True)
    st_c = _side_state(h_ctx, lp, False)
    qu_c = _side_query(h_ctx, lp, False) if ctx_out else None
    log_gamma = -jnp.exp(lp['ret_log_decay'].astype(jnp.float32))
    b = h_lat.shape[0]
    zero_ret = jnp.zeros((b, RET_HEADS, RET_HEAD_DIM, RET_HEAD_DIM), jnp.float32)
    zero_rw = jnp.zeros((b, RWKV_HEADS, RWKV_HEAD_DIM, RWKV_HEAD_DIM), jnp.float32)
    ret_l, rw_l, ret_c, rw_c = [], [], [], []
    for d, f in enumerate((_ident, _flip)):
        if ctx_out:
            o, r_state = _retention_chunkwise(f(qu_c['ret_q']), f(st_c['ret_k']), f(st_c['ret_v']), log_gamma[d], zero_ret)
            ret_c.append(f(o))
        else:
            r_state = _retention_final_state(f(st_c['ret_k']), f(st_c['ret_v']), log_gamma[d])
        o, _ = _retention_chunkwise(f(qu_l['ret_q']), f(st_l['ret_k']), f(st_l['ret_v']), log_gamma[d], r_state)
        ret_l.append(f(o))
        s_state, o = _rwkv7_scan(zero_rw, f(st_c['w'][d]), f(st_c['k'][d]), f(st_c['v']), f(st_c['kk']),
                                 f(st_c['a'][d]), f(qu_c['r']) if ctx_out else None)
        if ctx_out:
            rw_c.append(f(o))
        _, o = _rwkv7_scan(s_state, f(st_l['w'][d]), f(st_l['k'][d]), f(st_l['v']), f(st_l['kk']),
                           f(st_l['a'][d]), f(qu_l['r']))
        rw_l.append(f(o))
    y_lat = _branch_merge(ret_l[0] + ret_l[1], rw_l[0] + rw_l[1], st_l, qu_l, lp)
    y_ctx = _branch_merge(ret_c[0] + ret_c[1], rw_c[0] + rw_c[1], st_c, qu_c, lp) if ctx_out else None
    return y_lat, y_ctx


def _expert_choice_ffn(h, w_router, w_gate, w_up, w_down):
    b, n, d = h.shape
    cap = CAPACITY_FACTOR * n // N_EXPERTS
    aff = jax.nn.softmax((h @ w_router).astype(jnp.float32), axis=-1)
    gate, idx = lax.top_k(jnp.swapaxes(aff, 1, 2), cap)
    xg = jax.vmap(lambda hb, ib: hb[ib])(h, idx)
    hid = jax.nn.silu(jnp.einsum('becd,edf->becf', xg, w_gate)) * jnp.einsum('becd,edf->becf', xg, w_up)
    out = jnp.einsum('becf,efd->becd', hid, w_down) * gate[..., None].astype(h.dtype)
    return jax.vmap(lambda ob, ib: jnp.zeros((n, d), ob.dtype).at[ib.reshape(-1)].add(ob.reshape(-1, d)))(out, idx)


def setup_inputs(seed: int = 0) -> dict:
    key = jax.random.key(seed)
    ks = iter(jax.random.split(key, 32))
    f32 = jnp.float32

    def nrm(shape, scale):
        return scale * jax.random.normal(next(ks), shape, f32)

    L, D = DEPTH, D_MODEL
    ret_init = jnp.log(-jnp.log1p(-(2.0 ** (-5.0 - jnp.arange(RET_HEADS, dtype=f32)))))
    return {
        'x': nrm((BATCH, SEQ, D), 1.0),
        'c': nrm((BATCH, D), 1.0),
        'ctx': nrm((BATCH, CTX_LEN, D), 1.0),
        'c_ctx': nrm((D,), 1.0),
        'w_mod': nrm((L, D, N_MOD * D), 0.5 * D ** -0.5),
        'b_mod': nrm((L, N_MOD * D), 0.02),
        'norm_g': 1.0 + nrm((L, 4, D), 0.05),
        'w_in': nrm((L, D, IN_COLS), D ** -0.5),
        'ret_log_decay': ret_init[None, None, :] + nrm((L, 2, RET_HEADS), 0.1),
        'ret_gn_g': 1.0 + nrm((L, RET_WIDTH), 0.05),
        'rwkv_mu': jax.random.uniform(next(ks), (L, 2, SHIFT_COLS), f32, 0.0, 0.5),
        'rwkv_k_k': 0.85 + nrm((L, RWKV_WIDTH), 0.05),
        'rwkv_k_a': 1.0 + nrm((L, RWKV_WIDTH), 0.05),
        'rwkv_r_k': nrm((L, RWKV_WIDTH), 0.1),
        'rwkv_w0': jax.random.uniform(next(ks), (L, 2, RWKV_WIDTH), f32, -6.0, 0.0),
        'rwkv_w2': nrm((L, 2, DECAY_LORA, RWKV_WIDTH), 0.5 * DECAY_LORA ** -0.5),
        'rwkv_a0': nrm((L, 2, RWKV_WIDTH), 0.1),
        'rwkv_a2': nrm((L, 2, ICLR_LORA, RWKV_WIDTH), ICLR_LORA ** -0.5),
        'rwkv_g2': nrm((L, GATE_LORA, RWKV_WIDTH), GATE_LORA ** -0.5),
        'rwkv_ln_g': 1.0 + nrm((L, RWKV_WIDTH), 0.05),
        'rwkv_ln_b': nrm((L, RWKV_WIDTH), 0.02),
        'w_br_ret': nrm((L, RET_WIDTH, D), RET_WIDTH ** -0.5),
        'w_br_rwkv': nrm((L, RWKV_WIDTH, D), RWKV_WIDTH ** -0.5),
        'w_out': nrm((L, D, D), D ** -0.5),
        'w_router': nrm((L, D, N_EXPERTS), D ** -0.5),
        'w_gate': nrm((L, N_EXPERTS, D, EXPERT_FF), D ** -0.5),
        'w_up': nrm((L, N_EXPERTS, D, EXPERT_FF), D ** -0.5),
        'w_down': nrm((L, N_EXPERTS, EXPERT_FF, D), EXPERT_FF ** -0.5),
    }


def reference(x, c, ctx, c_ctx, w_mod, b_mod, norm_g, w_in, ret_log_decay, ret_gn_g, rwkv_mu,
              rwkv_k_k, rwkv_k_a, rwkv_r_k, rwkv_w0, rwkv_w2, rwkv_a0, rwkv_a2, rwkv_g2,
              rwkv_ln_g, rwkv_ln_b, w_br_ret, w_br_rwkv, w_out, w_router, w_gate, w_up, w_down):
    for l in range(DEPTH):
        last = l == DEPTH - 1
        lp = {'w_in': w_in[l], 'ret_log_decay': ret_log_decay[l], 'ret_gn_g': ret_gn_g[l],
              'rwkv_mu': rwkv_mu[l], 'rwkv_k_k': rwkv_k_k[l], 'rwkv_k_a': rwkv_k_a[l], 'rwkv_r_k': rwkv_r_k[l],
              'rwkv_w0': rwkv_w0[l], 'rwkv_w2': rwkv_w2[l], 'rwkv_a0': rwkv_a0[l], 'rwkv_a2': rwkv_a2[l],
              'rwkv_g2': rwkv_g2[l], 'rwkv_ln_g': rwkv_ln_g[l], 'rwkv_ln_b': rwkv_ln_b[l],
              'w_br_ret': w_br_ret[l], 'w_br_rwkv': w_br_rwkv[l], 'w_out': w_out[l]}
        ng = norm_g[l]
        sh1, sc1, g1, sh2, sc2, g2 = jnp.split((jax.nn.silu(c) @ w_mod[l] + b_mod[l])[:, None, :], N_MOD, axis=-1)
        csh1, csc1, cg1, csh2, csc2, cg2 = jnp.split(jax.nn.silu(c_ctx) @ w_mod[l] + b_mod[l], N_MOD, axis=-1)
        h_lat = _rmsnorm(x, ng[0]) * (1.0 + sc1) + sh1
        h_ctx = _rmsnorm(ctx, ng[0]) * (1.0 + csc1) + csh1
        y_lat, y_ctx = _token_mixer(h_lat, h_ctx, lp, not last)
        x = x + g1 * _rmsnorm(y_lat, ng[1])
        h2 = _rmsnorm(x, ng[2]) * (1.0 + sc2) + sh2
        x = x + g2 * _rmsnorm(_expert_choice_ffn(h2, w_router[l], w_gate[l], w_up[l], w_down[l]), ng[3])
        if not last:
            ctx = ctx + cg1 * _rmsnorm(y_ctx, ng[1])
            hc2 = _rmsnorm(ctx, ng[2]) * (1.0 + csc2) + csh2
            ctx = ctx + cg2 * _rmsnorm(_expert_choice_ffn(hc2, w_router[l], w_gate[l], w_up[l], w_down[l]), ng[3])
    return x
```

```cpp
#include <hip/hip_runtime.h>
#include <cstdio>
#include <cstdint>

#ifndef MK_N_LAUNCHES
#define MK_N_LAUNCHES 1
#endif

constexpr int D = 1024, NB = 16, T = 2048, CL = 256, GRIDW = 64;
constexpr int RH = 4, RD = 128, RW = 512;
constexpr int WH = 8, WD = 64, WW = 512;
constexpr int NE = 16, FF = 1024, CAP = 2 * T / NE;
constexpr int NTOK = NB * T, NCTX = NB * CL, NROW = NTOK + NCTX;
constexpr int INC = 5888;
constexpr int NMODC = 6 * D;
constexpr float NORM_EPS = 1e-6f;
static_assert(CAP == 256, "cap");

constexpr size_t MiB = 1u << 20;
constexpr size_t WS_CTL = 0, CTL_ZERO_BYTES = 1 * MiB;
constexpr size_t WS_SM = 1 * MiB;
constexpr size_t SM_MOD = WS_SM;
constexpr size_t SM_CS = SM_MOD + 512 * 1024;
constexpr size_t SM_KN = SM_CS + 64 * 1024;
constexpr size_t SM_BS = SM_KN + 1280 * 1024;
constexpr size_t SM_AFF = SM_BS + 2 * MiB;
constexpr size_t SM_IDX = SM_AFF + 2 * MiB;
constexpr size_t SM_GATE = SM_IDX + 256 * 1024;
constexpr size_t SM_SEL = SM_GATE + 256 * 1024;
constexpr size_t SM_W2T = SM_SEL + 2 * MiB;
constexpr size_t SM_A2T = SM_W2T + 128 * 1024;
constexpr size_t SM_G2T = SM_A2T + 128 * 1024;
constexpr size_t SM_WRT = SM_G2T + 128 * 1024;
static_assert(SM_WRT + 64 * 1024 <= 16 * MiB, "small region");
constexpr size_t WS_WBRRET = 16 * MiB, WS_WBRRW = 17 * MiB, WS_WOUT = 18 * MiB;
constexpr size_t WS_Z6 = 20 * MiB, WS_Z4 = 148 * MiB, WS_Z2 = 180 * MiB, WS_Z5 = 270 * MiB, WS_Z1 = 302 * MiB, WS_Z3 = 374 * MiB;
constexpr size_t WS_H = 406 * MiB, WS_WINT = 478 * MiB;
constexpr size_t WS_ARET = 406 * MiB, WS_WL = 438 * MiB, WS_OF = 302 * MiB, WS_OB = 334 * MiB, WS_ARW = 374 * MiB;
constexpr size_t WS_YLAT = 180 * MiB, WS_H2 = 244 * MiB, WS_WGU = 20 * MiB, WS_WDN = 84 * MiB, WS_XG = 308 * MiB, WS_HID = 116 * MiB, WS_Y = 244 * MiB;
constexpr size_t WS_END = 512 * MiB;
constexpr size_t OUT_RST = 72 * MiB;
constexpr int Z1P = 1024, Z2P = 1280, Z3P = 512, Z4P = 512, Z5P = 512, Z6P = 2048;

namespace pg8 {
#define PG8_LAS __attribute__((address_space(3)))
typedef unsigned short bf16_t;
typedef short bf16x8 __attribute__((ext_vector_type(8)));
typedef float f32x4 __attribute__((ext_vector_type(4)));
typedef unsigned u32x4 __attribute__((ext_vector_type(4)));
constexpr int BM = 256, BK = 64, HALF = 128, HTB = HALF * BK * 2, STAGE_BYTES = 8 * HTB;

__host__ __device__ __forceinline__ int lds_byte(int r, int c) { const int st = (r >> 4) * 2 + (c >> 5), rr = r & 15, cc = c & 31, ob = rr * 64 + cc * 2; return st * 1024 + (ob ^ (((ob >> 9) & 1) << 5)); }
__host__ __device__ __forceinline__ void stage_rc(int b, int& R, int& C) { const int st = b / 1024, sb = b % 1024, swz = sb ^ (((sb >> 9) & 1) << 5); R = (st >> 1) * 16 + swz / 64; C = (st & 1) * 32 + (swz % 64) / 2; }
__host__ __device__ __forceinline__ int perm32(int rho) { const int n = rho >> 4, i = rho & 15; return 8 * (i >> 2) + 4 * n + (i & 3); }

struct Unit { int pm, pn; };
typedef __bf16 bf16x2_t __attribute__((ext_vector_type(2)));
typedef float f32x2_t __attribute__((ext_vector_type(2)));
__device__ __forceinline__ unsigned cvt_pk_bf16(float lo, float hi) { const f32x2_t v = {lo, hi}; return __builtin_bit_cast(unsigned, __builtin_convertvector(v, bf16x2_t)); }

template <class Epi, class Sched, bool GATHER = false>
__device__ __forceinline__ void gemm_phase(PG8_LAS unsigned char* lds, const int K, const Sched& S, const Epi& E) {
    const int tid = threadIdx.x, wid = __builtin_amdgcn_readfirstlane(tid >> 6), lane = tid & 63, wr = wid >> 2, wc = wid & 3, fr = lane & 15, fq = lane >> 4;
    const int nt = K / BK;
    unsigned voffA[2], voffB[2];
#pragma unroll
    for (int i = 0; i < 2; ++i) { int R, C; stage_rc(tid * 16 + i * 8192, R, C); const int Rb = (R & ~31) + perm32(R & 31);
        voffA[i] = (unsigned)(R * K + C) * 2u; voffB[i] = (unsigned)(Rb * K + C) * 2u; }
    const size_t kstep = (size_t)(BK * 2);
    const size_t hstep = (size_t)HALF * K * 2;
    const unsigned ldsw = (unsigned)wid * 1024u;
    const int aoff = lds_byte(wr * 64 + fr, fq * 8), boff = lds_byte(wc * 32 + fr, fq * 8);
#define PG8_SA(b, h) (((b) * 2 + (h)) * HTB)
#define PG8_SB(b, h) ((4 + (b) * 2 + (h)) * HTB)
#define PG8_STAGE(bufoff, gbase, voff) do { _Pragma("unroll") for (int _i = 0; _i < 2; ++_i) \
        __builtin_amdgcn_global_load_lds((const unsigned*)((const char*)(gbase) + (voff)[_i]), (PG8_LAS unsigned*)(lds + (bufoff) + ldsw + _i * 8192), 16, 0, 0); } while (0)
#define PG8_LDA(dst, b, h) do { _Pragma("unroll") for (int m = 0; m < 4; ++m) _Pragma("unroll") for (int k = 0; k < 2; ++k) dst[m][k] = *(const PG8_LAS bf16x8*)(lds + PG8_SA(b, h) + aoff + m * 2048 + k * 1024); } while (0)
#define PG8_LDB(dst, b, h) do { _Pragma("unroll") for (int n = 0; n < 2; ++n) _Pragma("unroll") for (int k = 0; k < 2; ++k) dst[n][k] = *(const PG8_LAS bf16x8*)(lds + PG8_SB(b, h) + boff + n * 2048 + k * 1024); } while (0)
#define PG8_MMA(ai, bj, At, Bt) do { __builtin_amdgcn_s_setprio(1); _Pragma("unroll") for (int m = 0; m < 4; ++m) _Pragma("unroll") for (int n = 0; n < 2; ++n) _Pragma("unroll") for (int k = 0; k < 2; ++k) \
        acc[ai][bj][m][n] = __builtin_amdgcn_mfma_f32_16x16x32_bf16(Bt[n][k], At[m][k], acc[ai][bj][m][n], 0, 0, 0); __builtin_amdgcn_s_setprio(0); } while (0)
#define PG8_WAIT_V(n) asm volatile("s_waitcnt vmcnt(" #n ")" ::: "memory")
#define PG8_WAIT_L(n) asm volatile("s_waitcnt lgkmcnt(" #n ")" ::: "memory")
#define PG8_BAR __builtin_amdgcn_s_barrier()
#define PG8_SCHED __builtin_amdgcn_sched_barrier(0)
    Unit cur, nxt; int ui = 0;
    if (!S.next(0, cur)) return;
    f32x4 acc[2][2][4][2];
#pragma unroll
    for (int a = 0; a < 2; ++a)
#pragma unroll
        for (int b = 0; b < 2; ++b)
#pragma unroll
            for (int m = 0; m < 4; ++m)
#pragma unroll
                for (int n = 0; n < 2; ++n) acc[a][b][m][n] = (f32x4){0.f, 0.f, 0.f, 0.f};
    bf16x8 At[4][2], B0[2][2], B1[2][2];
    const char* cA = S.a_base(cur); const char* cB = S.b_base(cur);
    int srow[2], scol[2];
#pragma unroll
    for (int i = 0; i < 2; ++i) stage_rc(tid * 16 + i * 8192, srow[i], scol[i]);
    unsigned cO[2][2], nO[2][2];
    if constexpr (GATHER) {
#pragma unroll
        for (int h = 0; h < 2; ++h)
#pragma unroll
            for (int i = 0; i < 2; ++i) cO[h][i] = S.a_rowoff(cur, h * HALF + srow[i]) + (unsigned)scol[i] * 2u;
    }
#define PG8_STAGE_A(bufoff, gbase, h, OFF) do { if constexpr (GATHER) { _Pragma("unroll") for (int _i = 0; _i < 2; ++_i) \
        __builtin_amdgcn_global_load_lds((const unsigned*)((const char*)(gbase) + (OFF)[h][_i]), (PG8_LAS unsigned*)(lds + (bufoff) + ldsw + _i * 8192), 16, 0, 0); } \
        else { PG8_STAGE(bufoff, (gbase) + (h) * hstep, voffA); } } while (0)
    PG8_STAGE(PG8_SB(0, 0), cB, voffB); PG8_STAGE(PG8_SB(0, 1), cB + hstep, voffB); PG8_STAGE_A(PG8_SA(0, 0), cA, 0, cO); PG8_STAGE_A(PG8_SA(0, 1), cA, 1, cO);
    if (wr == 1) PG8_BAR;
    PG8_WAIT_V(2); PG8_BAR;
    PG8_STAGE(PG8_SB(1, 0), cB + kstep, voffB); PG8_STAGE_A(PG8_SA(1, 0), cA + kstep, 0, cO); PG8_STAGE(PG8_SB(1, 1), cB + hstep + kstep, voffB);
    PG8_WAIT_V(6); PG8_BAR;
    for (;;) {
        const bool has_next = S.next(ui + 1, nxt);
        const char* nA = has_next ? S.a_base(nxt) : cA; const char* nB = has_next ? S.b_base(nxt) : cB;
        if constexpr (GATHER) {
#pragma unroll
            for (int h = 0; h < 2; ++h)
#pragma unroll
                for (int i = 0; i < 2; ++i) nO[h][i] = has_next ? S.a_rowoff(nxt, h * HALF + srow[i]) + (unsigned)scol[i] * 2u : cO[h][i];
        }
        for (int t = 0; t < nt; t += 2) {
            const bool last = (t == nt - 2);
            unsigned xO[2][2];
            if constexpr (GATHER) {
#pragma unroll
                for (int h = 0; h < 2; ++h)
#pragma unroll
                    for (int i = 0; i < 2; ++i) xO[h][i] = last ? nO[h][i] : cO[h][i];
            }
            const char* a1 = cA + (size_t)(t + 1) * kstep;
            const char* a2 = last ? nA : cA + (size_t)(t + 2) * kstep; const char* b2 = last ? nB : cB + (size_t)(t + 2) * kstep;
            const char* a3 = a2 + kstep; const char* b3 = b2 + kstep;
            PG8_LDB(B0, 0, 0); PG8_LDB(B1, 0, 1); PG8_SCHED; PG8_LDA(At, 0, 0); PG8_STAGE_A(PG8_SA(1, 1), a1, 1, cO);
            PG8_WAIT_V(8); PG8_WAIT_L(0); PG8_BAR; PG8_MMA(0, 0, At, B0); PG8_MMA(0, 1, At, B1); PG8_BAR; PG8_SCHED;
            PG8_LDA(At, 0, 1); PG8_STAGE(PG8_SB(0, 0), b2, voffB); PG8_STAGE(PG8_SB(0, 1), b2 + hstep, voffB); PG8_STAGE_A(PG8_SA(0, 0), a2, 0, xO);
            PG8_WAIT_V(8); PG8_WAIT_L(0); PG8_BAR; PG8_MMA(1, 0, At, B0); PG8_MMA(1, 1, At, B1); PG8_BAR; PG8_SCHED;
            PG8_LDB(B0, 1, 0); PG8_LDB(B1, 1, 1); PG8_SCHED; PG8_LDA(At, 1, 0); PG8_STAGE_A(PG8_SA(0, 1), a2, 1, xO);
            PG8_WAIT_V(8); PG8_WAIT_L(0); PG8_BAR; PG8_MMA(0, 0, At, B0); PG8_MMA(0, 1, At, B1); PG8_BAR; PG8_SCHED;
            PG8_LDA(At, 1, 1); PG8_STAGE(PG8_SB(1, 0), b3, voffB); PG8_STAGE(PG8_SB(1, 1), b3 + hstep, voffB); PG8_STAGE_A(PG8_SA(1, 0), a3, 0, xO);
            PG8_WAIT_V(8); PG8_WAIT_L(0); PG8_BAR; PG8_MMA(1, 0, At, B0); PG8_MMA(1, 1, At, B1); PG8_BAR; PG8_SCHED;
        }
        if (wr == 0) PG8_BAR;
        E(acc, cur, wr, wc, fr, fq);
        if (!has_next) break;
#pragma unroll
        for (int a = 0; a < 2; ++a)
#pragma unroll
            for (int b = 0; b < 2; ++b)
#pragma unroll
                for (int m = 0; m < 4; ++m)
#pragma unroll
                    for (int n = 0; n < 2; ++n) acc[a][b][m][n] = (f32x4){0.f, 0.f, 0.f, 0.f};
        cur = nxt; cA = nA; cB = nB; ++ui;
        if constexpr (GATHER) {
#pragma unroll
            for (int h = 0; h < 2; ++h)
#pragma unroll
                for (int i = 0; i < 2; ++i) cO[h][i] = nO[h][i];
        }
        if (wr == 1) PG8_BAR;
    }
    PG8_WAIT_V(0);
    PG8_BAR;
#undef PG8_SA
#undef PG8_SB
#undef PG8_STAGE
#undef PG8_STAGE_A
#undef PG8_LDA
#undef PG8_LDB
#undef PG8_MMA
#undef PG8_WAIT_V
#undef PG8_WAIT_L
#undef PG8_BAR
#undef PG8_SCHED
}
typedef int i32x8 __attribute__((ext_vector_type(8)));
typedef int i32x4 __attribute__((ext_vector_type(4)));
__device__ __forceinline__ i32x8 f8cat(const bf16x8 lo, const bf16x8 hi) { const u32x4 a = __builtin_bit_cast(u32x4, lo), b = __builtin_bit_cast(u32x4, hi);
    i32x8 r; r[0] = (int)a.x; r[1] = (int)a.y; r[2] = (int)a.z; r[3] = (int)a.w; r[4] = (int)b.x; r[5] = (int)b.y; r[6] = (int)b.z; r[7] = (int)b.w; return r; }
template <class Epi, class Sched, bool GATHER = false>
__device__ __forceinline__ void gemm_phase_f8(PG8_LAS unsigned char* lds, const int K  , const Sched& S, const Epi& E) {
    const int tid = threadIdx.x, wid = __builtin_amdgcn_readfirstlane(tid >> 6), lane = tid & 63, wr = wid >> 2, wc = wid & 3, fr = lane & 15, fq = lane >> 4;
    const int nt = K / 128;
    unsigned voffA[2], voffB[2];
#pragma unroll
    for (int i = 0; i < 2; ++i) { int R, C; stage_rc(tid * 16 + i * 8192, R, C); const int Rb = (R & ~31) + perm32(R & 31);
        voffA[i] = (unsigned)(R * K + C * 2); voffB[i] = (unsigned)(Rb * K + C * 2); }
    const unsigned kstep = 128u;
    const unsigned hstep = (unsigned)(HALF * K);
    const __amdgpu_buffer_rsrc_t rsA = __builtin_amdgcn_make_buffer_rsrc((void*)S.a_root(), 0, 0x7fffffff, 0x00020000), rsB = __builtin_amdgcn_make_buffer_rsrc((void*)S.b_root(), 0, 0x7fffffff, 0x00020000);
    const unsigned ldsw = (unsigned)wid * 1024u;
    const int aoff0 = lds_byte(wr * 64 + fr, fq * 16), boff0 = lds_byte(wc * 32 + fr, fq * 16);
#define PG8_SA(b, h) (((b) * 2 + (h)) * HTB)
#define PG8_SB(b, h) ((4 + (b) * 2 + (h)) * HTB)
#define PG8_STAGE(bufoff, gbase, voff) do { _Pragma("unroll") for (int _i = 0; _i < 2; ++_i) \
        __builtin_amdgcn_raw_ptr_buffer_load_lds(rsB, (PG8_LAS void*)(lds + (bufoff) + ldsw + _i * 8192), 16, (voff)[_i], (gbase), 0, 0); } while (0)
#define PG8_LDA(dst, b, h) do { _Pragma("unroll") for (int m = 0; m < 4; ++m) dst[m] = __builtin_shufflevector(*(const PG8_LAS i32x4*)(lds + PG8_SA(b, h) + aoff0 + m * 2048), *(const PG8_LAS i32x4*)(lds + PG8_SA(b, h) + aoff0 + 16 + m * 2048), 0, 1, 2, 3, 4, 5, 6, 7); } while (0)
#define PG8_LDB(dst, b, h) do { _Pragma("unroll") for (int n = 0; n < 2; ++n) dst[n] = __builtin_shufflevector(*(const PG8_LAS i32x4*)(lds + PG8_SB(b, h) + boff0 + n * 2048), *(const PG8_LAS i32x4*)(lds + PG8_SB(b, h) + boff0 + 16 + n * 2048), 0, 1, 2, 3, 4, 5, 6, 7); } while (0)
#define PG8_MMA(ai, bj, At, Bt) do { __builtin_amdgcn_s_setprio(1); _Pragma("unroll") for (int m = 0; m < 4; ++m) _Pragma("unroll") for (int n = 0; n < 2; ++n) \
        acc[ai][bj][m][n] = __builtin_amdgcn_mfma_scale_f32_16x16x128_f8f6f4(Bt[n], At[m], acc[ai][bj][m][n], 0, 0, 0, 0x7F7F7F7F, 0, 0x7F7F7F7F); __builtin_amdgcn_s_setprio(0); } while (0)
#define PG8_WAIT_V(n) asm volatile("s_waitcnt vmcnt(" #n ")" ::: "memory")
#define PG8_WAIT_L(n) asm volatile("s_waitcnt lgkmcnt(" #n ")" ::: "memory")
#define PG8_BAR __builtin_amdgcn_s_barrier()
#define PG8_SCHED __builtin_amdgcn_sched_barrier(0)
    Unit cur, nxt; int ui = 0;
    if (!S.next(0, cur)) return;
    f32x4 acc[2][2][4][2];
#pragma unroll
    for (int a = 0; a < 2; ++a)
#pragma unroll
        for (int b = 0; b < 2; ++b)
#pragma unroll
            for (int m = 0; m < 4; ++m)
#pragma unroll
                for (int n = 0; n < 2; ++n) acc[a][b][m][n] = (f32x4){0.f, 0.f, 0.f, 0.f};
    i32x8 At[4], B0[2], B1[2];
    unsigned cA = S.a_off(cur), cB = S.b_off(cur);
    int srow[2], scol[2];
#pragma unroll
    for (int i = 0; i < 2; ++i) stage_rc(tid * 16 + i * 8192, srow[i], scol[i]);
    unsigned cO[2][2];
    if constexpr (GATHER) {
#pragma unroll
        for (int h = 0; h < 2; ++h)
#pragma unroll
            for (int i = 0; i < 2; ++i) cO[h][i] = S.a_rowoff(cur, h * HALF + srow[i]) + (unsigned)scol[i] * 2u;
    }
#define PG8_STAGE_A(bufoff, gbase, h, OFF) do { _Pragma("unroll") for (int _i = 0; _i < 2; ++_i) \
        __builtin_amdgcn_raw_ptr_buffer_load_lds(rsA, (PG8_LAS void*)(lds + (bufoff) + ldsw + _i * 8192), 16, GATHER ? (OFF)[h][_i] : voffA[_i], GATHER ? (gbase) : (gbase) + (h) * hstep, 0, 0); } while (0)
    PG8_STAGE(PG8_SB(0, 0), cB, voffB); PG8_STAGE(PG8_SB(0, 1), cB + hstep, voffB); PG8_STAGE_A(PG8_SA(0, 0), cA, 0, cO); PG8_STAGE_A(PG8_SA(0, 1), cA, 1, cO);
    if (wr == 1) PG8_BAR;
    PG8_WAIT_V(2); PG8_BAR;
    PG8_STAGE(PG8_SB(1, 0), cB + kstep, voffB); PG8_STAGE_A(PG8_SA(1, 0), cA + kstep, 0, cO); PG8_STAGE(PG8_SB(1, 1), cB + hstep + kstep, voffB);
    PG8_WAIT_V(6); PG8_BAR;
    for (;;) {
        const bool has_next = S.next(ui + 1, nxt);
        const unsigned nA = has_next ? S.a_off(nxt) : cA, nB = has_next ? S.b_off(nxt) : cB;
        if constexpr (GATHER) {
            u32x4 pk; pk.x = has_next ? S.a_rowoff(nxt, srow[0]) + (unsigned)scol[0] * 2u : cO[0][0]; pk.y = has_next ? S.a_rowoff(nxt, srow[1]) + (unsigned)scol[1] * 2u : cO[0][1];
            pk.z = has_next ? S.a_rowoff(nxt, HALF + srow[0]) + (unsigned)scol[0] * 2u : cO[1][0]; pk.w = has_next ? S.a_rowoff(nxt, HALF + srow[1]) + (unsigned)scol[1] * 2u : cO[1][1];
            *(PG8_LAS u32x4*)(lds + STAGE_BYTES + tid * 16) = pk;
        }
#pragma unroll 1
        for (int t = 0; t < nt; t += 2) {
            const bool last = (t == nt - 2);
            const unsigned a1 = cA + (unsigned)(t + 1) * kstep;
            const unsigned a2 = last ? nA : cA + (unsigned)(t + 2) * kstep, b2 = last ? nB : cB + (unsigned)(t + 2) * kstep;
            const unsigned a3 = a2 + kstep, b3 = b2 + kstep;
            PG8_LDB(B0, 0, 0); PG8_LDB(B1, 0, 1); PG8_SCHED; PG8_LDA(At, 0, 0); PG8_STAGE_A(PG8_SA(1, 1), a1, 1, cO);
            if constexpr (GATHER) { if (last) {
                const u32x4 nv = *(const PG8_LAS u32x4*)(lds + STAGE_BYTES + tid * 16); cO[0][0] = nv.x; cO[0][1] = nv.y; cO[1][0] = nv.z; cO[1][1] = nv.w; } }
            PG8_WAIT_V(8); PG8_WAIT_L(0); PG8_BAR; PG8_MMA(0, 0, At, B0); PG8_MMA(0, 1, At, B1); PG8_BAR; PG8_SCHED;
            PG8_LDA(At, 0, 1); PG8_STAGE(PG8_SB(0, 0), b2, voffB); PG8_STAGE(PG8_SB(0, 1), b2 + hstep, voffB); PG8_STAGE_A(PG8_SA(0, 0), a2, 0, cO);
            PG8_WAIT_V(8); PG8_WAIT_L(0); PG8_BAR; PG8_MMA(1, 0, At, B0); PG8_MMA(1, 1, At, B1); PG8_BAR; PG8_SCHED;
            PG8_LDB(B0, 1, 0); PG8_LDB(B1, 1, 1); PG8_SCHED; PG8_LDA(At, 1, 0); PG8_STAGE_A(PG8_SA(0, 1), a2, 1, cO);
            PG8_WAIT_V(8); PG8_WAIT_L(0); PG8_BAR; PG8_MMA(0, 0, At, B0); PG8_MMA(0, 1, At, B1); PG8_BAR; PG8_SCHED;
            PG8_LDA(At, 1, 1); PG8_STAGE(PG8_SB(1, 0), b3, voffB); PG8_STAGE(PG8_SB(1, 1), b3 + hstep, voffB); PG8_STAGE_A(PG8_SA(1, 0), a3, 0, cO);
            PG8_WAIT_V(8); PG8_WAIT_L(0); PG8_BAR; PG8_MMA(1, 0, At, B0); PG8_MMA(1, 1, At, B1); PG8_BAR; PG8_SCHED;
        }
        if (wr == 0) PG8_BAR;
        E(acc, cur, wr, wc, fr, fq);
        if (!has_next) break;
#pragma unroll
        for (int a = 0; a < 2; ++a)
#pragma unroll
            for (int b = 0; b < 2; ++b)
#pragma unroll
                for (int m = 0; m < 4; ++m)
#pragma unroll
                    for (int n = 0; n < 2; ++n) acc[a][b][m][n] = (f32x4){0.f, 0.f, 0.f, 0.f};
        cur = nxt; cA = nA; cB = nB; ++ui;
        if (wr == 1) PG8_BAR;
    }
    PG8_WAIT_V(0);
    PG8_BAR;
#undef PG8_SA
#undef PG8_SB
#undef PG8_STAGE
#undef PG8_STAGE_A
#undef PG8_LDA
#undef PG8_LDB
#undef PG8_MMA
#undef PG8_WAIT_V
#undef PG8_WAIT_L
#undef PG8_BAR
#undef PG8_SCHED
}
}

#define GAS __attribute__((address_space(1)))
#define LAS __attribute__((address_space(3)))
typedef unsigned short bf16;
typedef unsigned v4u __attribute__((ext_vector_type(4)));
typedef unsigned v2u __attribute__((ext_vector_type(2)));
typedef float f32x4 __attribute__((ext_vector_type(4)));
typedef GAS unsigned gu32;
#define RLX_AGENT __ATOMIC_RELAXED, __HIP_MEMORY_SCOPE_AGENT
#define LDS_WAIT() asm volatile("s_waitcnt lgkmcnt(0)" ::: "memory")
#define VM_WAIT() asm volatile("s_waitcnt vmcnt(0)" ::: "memory")
__device__ __forceinline__ unsigned f2bf(float f) { unsigned u = __builtin_bit_cast(unsigned, f); return (u + 0x7fffu + ((u >> 16) & 1u)) >> 16; }
__device__ __forceinline__ unsigned pk2(float lo, float hi) { return pg8::cvt_pk_bf16(lo, hi); }
__device__ __forceinline__ float bf2f(unsigned b) { return __builtin_bit_cast(float, b << 16); }
__device__ __forceinline__ float bflo(unsigned w) { return __builtin_bit_cast(float, w << 16); }
__device__ __forceinline__ float bfhi(unsigned w) { return __builtin_bit_cast(float, w & 0xffff0000u); }
template <int CTRL> __device__ __forceinline__ float dpp_f(float v) { return __builtin_bit_cast(float, __builtin_amdgcn_update_dpp(0, __builtin_bit_cast(int, v), CTRL, 0xf, 0xf, true)); }
__device__ __forceinline__ float swap32_add(float a, float b) { const auto r = __builtin_amdgcn_permlane32_swap(__builtin_bit_cast(unsigned, a), __builtin_bit_cast(unsigned, b), false, false);
    return __builtin_bit_cast(float, (unsigned)r[0]) + __builtin_bit_cast(float, (unsigned)r[1]); }
__device__ __forceinline__ float swap16_add(float a, float b) { const auto r = __builtin_amdgcn_permlane16_swap(__builtin_bit_cast(unsigned, a), __builtin_bit_cast(unsigned, b), false, false);
    return __builtin_bit_cast(float, (unsigned)r[0]) + __builtin_bit_cast(float, (unsigned)r[1]); }
__device__ __forceinline__ float swap16_max(float a) { const auto r = __builtin_amdgcn_permlane16_swap(__builtin_bit_cast(unsigned, a), __builtin_bit_cast(unsigned, a), false, false);
    return fmaxf(__builtin_bit_cast(float, (unsigned)r[0]), __builtin_bit_cast(float, (unsigned)r[1])); }
__device__ __forceinline__ float dpp_xor4(float v) {
    const int x = __builtin_bit_cast(int, v); int r = __builtin_amdgcn_update_dpp(0, x, 0x114, 0xf, 0xA, false); r = __builtin_amdgcn_update_dpp(r, x, 0x104, 0xf, 0x5, false); return __builtin_bit_cast(float, r); }
__device__ __forceinline__ float red8(float v) { v += dpp_f<0xB1>(v); v += dpp_f<0x4E>(v); v += dpp_f<0x141>(v); return v; }
__device__ __forceinline__ float wave_sum_dpp(float v) {
    v += dpp_f<0xB1>(v); v += dpp_f<0x4E>(v); v += dpp_f<0x141>(v); v += dpp_f<0x140>(v);
    const int vi = __builtin_bit_cast(int, v);
    return (__builtin_bit_cast(float, __builtin_amdgcn_readlane(vi, 0)) + __builtin_bit_cast(float, __builtin_amdgcn_readlane(vi, 16))) +
           (__builtin_bit_cast(float, __builtin_amdgcn_readlane(vi, 32)) + __builtin_bit_cast(float, __builtin_amdgcn_readlane(vi, 48)));
}
__device__ __forceinline__ float wave_sum(float v) { return wave_sum_dpp(v); }
__device__ __forceinline__ float sigmoidf_(float x) { return __builtin_amdgcn_rcpf(1.f + __expf(-x)); }
__device__ __forceinline__ float siluf_(float x) { return x * __builtin_amdgcn_rcpf(1.f + __expf(-x)); }

#define XB_TMO      128
#define XB_XCNT(j)  (256  + 64 * (j))
#define XB_XSUB(j)  (1280 + 64 * (j))
#define XB_XGEN(j)  (2304 + 64 * (j))
#define XB_TOP      3328
#define XB_TOPGEN   3392
#define XCD_BAR_WORDS 3456
#define XB_SPIN_CAP (1u << 22)
__device__ __forceinline__ unsigned xb_ld(unsigned* p)              { return __hip_atomic_load(p, __ATOMIC_RELAXED, __HIP_MEMORY_SCOPE_AGENT); }
__device__ __forceinline__ unsigned xb_add(unsigned* p, unsigned v) { return __hip_atomic_fetch_add(p, v, __ATOMIC_RELAXED, __HIP_MEMORY_SCOPE_AGENT); }
__device__ __forceinline__ unsigned xb_xcc_id() { return (unsigned)__builtin_amdgcn_s_getreg((3 << 11) | 20) & 0xFu; }
#define XB_SPIN(cond, bar) do { unsigned _sp = 0; while (cond) { __builtin_amdgcn_s_sleep(1); \
    if ((++_sp & 255u) == 0u) { if (xb_ld(&(bar)[XB_TMO])) break; if (_sp > XB_SPIN_CAP) { atomicAdd(&(bar)[XB_TMO], 1u); break; } } } } while (0)
struct XcdBarrier { unsigned* bar; unsigned x; volatile LAS unsigned* st; };
__device__ __forceinline__ XcdBarrier xcd_barrier_post(unsigned* bar, volatile LAS unsigned* st) {
    XcdBarrier b; b.bar = bar; b.x = xb_xcc_id(); b.st = st;
    if (threadIdx.x == 0) (void)xb_add(&bar[XB_XCNT(b.x)], 1u);
    return b;
}
__device__ __forceinline__ void xcd_barrier_complete(unsigned* bar, unsigned x, unsigned& nloc, unsigned& nx) {
    const unsigned G = gridDim.x * gridDim.y * gridDim.z;
    unsigned sum, cnt, mine, sp = 0u;
    for (;;) {
        sum = 0u; cnt = 0u; mine = 0u;
#pragma unroll
        for (unsigned j = 0; j < 16; ++j) { const unsigned c = xb_ld(&bar[XB_XCNT(j)]); sum += c; cnt += (c > 0u) ? 1u : 0u; mine = (j == x) ? c : mine; }
        if (sum == G) break;
        __builtin_amdgcn_s_sleep(1);
        if ((++sp & 255u) == 0u) { if (xb_ld(&bar[XB_TMO])) break; if (sp > XB_SPIN_CAP) { atomicAdd(&bar[XB_TMO], 1u); break; } }
    }
    nloc = mine > 0u ? mine : 1u; nx = cnt > 0u ? cnt : 1u;
}
__device__ __forceinline__ void xcd_barrier(const XcdBarrier& b) {
    asm volatile("s_waitcnt vmcnt(0)" ::: "memory");
    __syncthreads();
    if (threadIdx.x == 0) {
        unsigned* bar = b.bar;
        __builtin_amdgcn_s_waitcnt(0);
        unsigned nloc = b.st[0], nx = b.st[1];
        if (nloc == 0u) { xcd_barrier_complete(bar, b.x, nloc, nx); b.st[0] = nloc; b.st[1] = nx; }
        const unsigned old = xb_add(&bar[XB_XSUB(b.x)], 1u);
        const unsigned gen = old / nloc;
        if (old + 1u == (gen + 1u) * nloc) {
            __builtin_amdgcn_fence(__ATOMIC_RELEASE, "agent");
            asm volatile("s_waitcnt vmcnt(0)" ::: "memory");
            const unsigned og = xb_add(&bar[XB_TOP], 1u);
            const unsigned tg = og / nx;
            if (og + 1u == (tg + 1u) * nx) xb_add(&bar[XB_TOPGEN], 1u);
            else XB_SPIN(xb_ld(&bar[XB_TOPGEN]) == tg, bar);
            __builtin_amdgcn_fence(__ATOMIC_ACQUIRE, "agent");
            xb_add(&bar[XB_XGEN(b.x)], 1u);
            asm volatile("s_waitcnt vmcnt(0)" ::: "memory");
        } else {
            XB_SPIN(xb_ld(&bar[XB_XGEN(b.x)]) == gen, bar);
            __builtin_amdgcn_fence(__ATOMIC_ACQUIRE, "agent");
            asm volatile("s_waitcnt vmcnt(0)" ::: "memory");
        }
    }
    __syncthreads();
}

constexpr int NWAVES = 8, NTHR = 512;
constexpr int RING_OFF = 0, RING_BYTES = 149504;
constexpr int LDSCTL_OFF = RING_BYTES, MISC_OFF = LDSCTL_OFF + 320;
constexpr int LDS_BYTES = 151552;
constexpr int CW_BAR = 4096;

struct Args { const float* in[28]; float* out; unsigned char* ws; int ph_lo, ph_hi, li, pad; };
enum { I_X = 0, I_C, I_CTX, I_CCTX, I_WMOD, I_BMOD, I_NORMG, I_WIN, I_RETLD, I_RETGN, I_MU, I_KK, I_KA, I_RK, I_W0, I_W2, I_A0, I_A2, I_G2, I_LNG, I_LNB,
       I_WBRRET, I_WBRRW, I_WOUT, I_WROUTER, I_WGATE, I_WUP, I_WDOWN };

struct Frame {
    LAS unsigned char* lds;
    int tid, lane, wave, G, bid;
    const float* const* in; float* out; unsigned char* ws;
};

__device__ __forceinline__ void transpose_load(f32x4 (&v)[8], const float* W, int ldn, int src_col0, int k0, int lane) {
#pragma unroll
    for (int i = 0; i < 8; ++i) v[i] = *(const f32x4*)(W + (size_t)(k0 + 8 * i + (lane >> 3)) * ldn + src_col0 + 4 * (lane & 7));
}
__device__ __forceinline__ void transpose_finish(const f32x4 (&v)[8], int K, bf16* WT, int dest_row0, int k0, LAS float* scr, int lane) {
#pragma unroll
    for (int i = 0; i < 8; ++i) { LAS float* d = scr + (8 * i + (lane >> 3)) * 33 + 4 * (lane & 7); d[0] = v[i].x; d[1] = v[i].y; d[2] = v[i].z; d[3] = v[i].w; }
    LDS_WAIT(); asm volatile("" ::: "memory");
    const int c = lane & 7;
#pragma unroll
    for (int j = 0; j < 4; ++j) { const int n = (lane >> 3) + 8 * j; const LAS float* s = scr + (8 * c) * 33 + n;
        v4u o; o.x = pk2(s[0 * 33], s[1 * 33]); o.y = pk2(s[2 * 33], s[3 * 33]); o.z = pk2(s[4 * 33], s[5 * 33]); o.w = pk2(s[6 * 33], s[7 * 33]);
        *(GAS v4u*)(WT + (size_t)(dest_row0 + n) * K + k0 + 8 * c) = o; }
    LDS_WAIT(); asm volatile("" ::: "memory");
}
__device__ __forceinline__ void transpose_item(const float* W, int ldn, int K, bf16* WT, int dest_row0, int src_col0, int k0, LAS float* scr, int lane) {
    f32x4 v[8]; transpose_load(v, W, ldn, src_col0, k0, lane); transpose_finish(v, K, WT, dest_row0, k0, scr, lane);
}
__device__ __forceinline__ unsigned f8x4(float a, float b, float c, float d) { int r = __builtin_amdgcn_cvt_pk_fp8_f32(a, b, 0, false); r = __builtin_amdgcn_cvt_pk_fp8_f32(c, d, r, true); return (unsigned)r; }
__device__ __forceinline__ void transpose_finish_f8(const f32x4 (&v)[8], int Kb, unsigned char* WT8, int dest_row0, int k0, LAS float* scr, int lane, float sc) {
#pragma unroll
    for (int i = 0; i < 8; ++i) { LAS float* d = scr + (8 * i + (lane >> 3)) * 33 + 4 * (lane & 7); d[0] = v[i].x * sc; d[1] = v[i].y * sc; d[2] = v[i].z * sc; d[3] = v[i].w * sc; }
    LDS_WAIT(); asm volatile("" ::: "memory");
    const int c = lane & 3;
#pragma unroll
    for (int j = 0; j < 2; ++j) { const int n = (lane >> 2) + 16 * j; const LAS float* s = scr + (16 * c) * 33 + n;
        v4u o; o.x = f8x4(s[0 * 33], s[1 * 33], s[2 * 33], s[3 * 33]); o.y = f8x4(s[4 * 33], s[5 * 33], s[6 * 33], s[7 * 33]);
        o.z = f8x4(s[8 * 33], s[9 * 33], s[10 * 33], s[11 * 33]); o.w = f8x4(s[12 * 33], s[13 * 33], s[14 * 33], s[15 * 33]);
        *(GAS v4u*)(WT8 + (size_t)(dest_row0 + n) * Kb + k0 + 16 * c) = o; }
    LDS_WAIT(); asm volatile("" ::: "memory");
}
constexpr float F8_WSCALE = 16.f, F8_HSCALE = 4.f;
__device__ __forceinline__ int win_orig_col(int c) {
    int cc = c;
    if (c < 512 || (c >= 2304 && c < 2816)) { const int tb = c & ~255, lc = c & 255; const int half = lc >> 7, hd = (lc & 127) >> 6, d1 = lc & 63; cc = tb + hd * 128 + half * 64 + d1; }
    return cc < 2176 ? cc : (cc < 2304 ? cc + 1536 : (cc < 3840 ? cc - 128 : cc));
}

__device__ __forceinline__ void p0_prologue(Frame& F) {
    LAS float* sil = (LAS float*)(F.lds);
    LAS float* red = (LAS float*)(F.lds + 17 * 1024 * 4);
    const float* cvec = F.in[I_C]; const float* cctx = F.in[I_CCTX]; const float* wmod = F.in[I_WMOD]; const float* bmod = F.in[I_BMOD];
    float* MOD = (float*)(F.ws + SM_MOD);
    { float tv[34];
#pragma unroll
      for (int q = 0; q < 34; ++q) { const int i = F.tid + NTHR * q, r = i >> 10, k = i & 1023; tv[q] = r < 16 ? cvec[r * 1024 + k] : cctx[k]; }
#pragma unroll
      for (int q = 0; q < 34; ++q) sil[F.tid + NTHR * q] = siluf_(tv[q]); }
    __syncthreads();
    for (int it = F.bid; it < NMODC / 24; it += F.G) {
        const int c0 = it * 24, kg = F.tid / 24, col = F.tid % 24;
        float acc[17];
#pragma unroll
        for (int r = 0; r < 17; ++r) acc[r] = 0.f;
        if (kg < 21) {
            for (int k0 = kg; k0 < 1024; k0 += 21 * 7) {
                float wv[7];
#pragma unroll
                for (int q = 0; q < 7; ++q) { const int k = k0 + 21 * q; wv[q] = wmod[(size_t)min(k, 1023) * NMODC + c0 + col]; }
#pragma unroll
                for (int q = 0; q < 7; ++q) { const int k = k0 + 21 * q; const float w = k < 1024 ? wv[q] : 0.f; const int kc = min(k, 1023);
#pragma unroll
                    for (int r = 0; r < 17; ++r) acc[r] += sil[r * 1024 + kc] * w; } }
#pragma unroll
            for (int r = 0; r < 17; ++r) red[(kg * 17 + r) * 24 + col] = acc[r];
        }
        __syncthreads();
        if (F.tid < 17 * 24) { const int r = F.tid / 24, cc = F.tid % 24; float s = bmod[c0 + cc];
            for (int g = 0; g < 21; ++g) s += red[(g * 17 + r) * 24 + cc];
            MOD[r * NMODC + c0 + cc] = s; }
        __syncthreads();
    }
    __syncthreads();
    LAS float* scr = (LAS float*)(F.lds + F.wave * 16384);
    const int gw = F.bid * NWAVES + F.wave, NGW = F.G * NWAVES;
    constexpr int I_IN = 16 * (INC / 32), I_BR = 8 * 32, I_OUT = 16 * 32;
    constexpr int I_LO = 32;
    constexpr int NITEMS = I_IN + 2 * I_BR + I_OUT + 3 * I_LO;
    bf16* WinT = (bf16*)(F.ws + WS_WINT); bf16* WbrRetT = (bf16*)(F.ws + WS_WBRRET); bf16* WbrRwT = (bf16*)(F.ws + WS_WBRRW); bf16* WoutT = (bf16*)(F.ws + WS_WOUT);
    for (int it = gw; it < NITEMS; it += NGW) {
        int r = it;
        if (r < I_IN) { const int kb = r / (INC / 32), nb = r % (INC / 32); transpose_item(F.in[I_WIN], INC, 1024, WinT, 32 * nb, win_orig_col(32 * nb), 64 * kb, scr, F.lane); continue; } r -= I_IN;
        if (r < I_BR) { const int kb = r / 32, nb = r % 32; transpose_item(F.in[I_WBRRET], 1024, 512, WbrRetT, 32 * nb, 32 * nb, 64 * kb, scr, F.lane); continue; } r -= I_BR;
        if (r < I_BR) { const int kb = r / 32, nb = r % 32; transpose_item(F.in[I_WBRRW], 1024, 512, WbrRwT, 32 * nb, 32 * nb, 64 * kb, scr, F.lane); continue; } r -= I_BR;
        if (r < I_OUT) { const int kb = r / 32, nb = r % 32; transpose_item(F.in[I_WOUT], 1024, 1024, WoutT, 32 * nb, 32 * nb, 64 * kb, scr, F.lane); continue; } r -= I_OUT;
        if (r < I_LO) { const int dd = r >> 4, nb = r & 15; transpose_item(F.in[I_W2] + dd * 64 * 512, 512, 64, (bf16*)(F.ws + SM_W2T) + dd * 512 * 64, 32 * nb, 32 * nb, 0, scr, F.lane); continue; } r -= I_LO;
        if (r < I_LO) { const int dd = r >> 4, nb = r & 15; transpose_item(F.in[I_A2] + dd * 64 * 512, 512, 64, (bf16*)(F.ws + SM_A2T) + dd * 512 * 64, 32 * nb, 32 * nb, 0, scr, F.lane); continue; } r -= I_LO;
        { const int kb = r >> 4, nb = r & 15; transpose_item(F.in[I_G2], 512, 128, (bf16*)(F.ws + SM_G2T), 32 * nb, 32 * nb, 64 * kb, scr, F.lane); }
    }
    if (F.bid < 16) { float* WRT = (float*)(F.ws + SM_WRT); const float* wr_ = F.in[I_WROUTER]; for (int k = F.tid; k < 1024; k += NTHR) WRT[F.bid * 1024 + k] = wr_[k * 16 + F.bid]; }
    if (F.bid == 0 && F.tid < 32) {
        const int f = F.tid; float* CS = (float*)(F.ws + SM_CS);
        const float invf = exp2f(-(float)f * (13.287712379549449f / 32.f));
        const double th = (double)invf;
        double sn = 0.0, cs = 0.0, term = 1.0;
        for (int n = 0; n < 24; ++n) { if ((n & 1) == 0) cs += ((n & 2) ? -term : term); else sn += ((n & 2) ? -term : term); term = term * th / (double)(n + 1); }
        double c = 1.0, s = 0.0;
        for (int pos = 0; pos < 64; ++pos) { CS[(pos * 32 + f) * 2] = (float)c; CS[(pos * 32 + f) * 2 + 1] = (float)s; const double c2 = c * cs - s * sn, s2 = s * cs + c * sn; c = c2; s = s2; }
    }
}

__device__ __forceinline__ void p1_hnorm(Frame& F) {
    const int gw = F.bid * NWAVES + F.wave, NGW = F.G * NWAVES;
    const float* MOD = (const float*)(F.ws + SM_MOD); const float* ng = F.in[I_NORMG];
    bf16* H = (bf16*)(F.ws + WS_H);
    for (int m = gw; m < NROW; m += NGW) {
        const float* src; int mr;
        if (m < NTOK) { src = F.in[I_X] + (size_t)m * D; mr = m / T; } else { src = F.in[I_CTX] + (size_t)(m - NTOK) * D; mr = 16; }
        const GAS f32x4* xr = (const GAS f32x4*)src + F.lane;
        f32x4 v[4]; float ss = 0.f;
#pragma unroll
        for (int j = 0; j < 4; ++j) { v[j] = xr[64 * j]; ss += (v[j].x * v[j].x + v[j].y * v[j].y) + (v[j].z * v[j].z + v[j].w * v[j].w); }
        const float rstd = __builtin_amdgcn_rsqf(wave_sum(ss) * (1.f / D) + NORM_EPS);
        GAS v2u* o8 = (GAS v2u*)(H + (size_t)m * D) + F.lane;
#pragma unroll
        for (int j = 0; j < 4; ++j) { const int k = 4 * F.lane + 256 * j;
            const f32x4 g = *(const f32x4*)(ng + k), sh = *(const f32x4*)(MOD + mr * NMODC + k), sc = *(const f32x4*)(MOD + mr * NMODC + 1024 + k);
            const f32x4 y = v[j] * rstd * g * (sc + 1.f) + sh;
            v2u w; w.x = pk2(y.x, y.y); w.y = pk2(y.z, y.w); o8[64 * j] = w; }
    }
}

struct SchedIn {
    int G, c; const char* A; const char* Bt;
    __device__ __forceinline__ bool next(int i, pg8::Unit& u) const {
        const int L = i * G + c; if (L >= 3072) return false;
        if (L < 2944) { const int g = L / 184, rem = L % 184; u.pn = rem >> 3; u.pm = g * 8 + (rem & 7); }
        else { const int l2 = L - 2944; u.pn = l2 >> 4; u.pm = 128 + (l2 & 15); }
        return true;
    }
    __device__ __forceinline__ const char* a_base(const pg8::Unit& u) const { return A + (size_t)u.pm * (256 * 1024 * 2); }
    __device__ __forceinline__ const char* b_base(const pg8::Unit& u) const { return Bt + (size_t)u.pn * (256 * 1024 * 2); }
};
struct EpiZ {
    unsigned char* ws;
    __device__ __forceinline__ void operator()(const pg8::f32x4 (&acc)[2][2][4][2], const pg8::Unit& u, int wr, int wc, int fr, int fq) const {
        bf16* base; int pitch, c0; const int pn = u.pn; float sc = 1.f;
        if (pn < 4) { base = (bf16*)(ws + WS_Z1); pitch = Z1P; c0 = pn * 256; if (pn < 2) sc = 0.08838834764831845f; }
        else if (pn < 9) { base = (bf16*)(ws + WS_Z2); pitch = Z2P; c0 = (pn - 4) * 256; }
        else if (pn < 11) { base = (bf16*)(ws + WS_Z3); pitch = Z3P; c0 = (pn - 9) * 256; }
        else if (pn < 13) { base = (bf16*)(ws + WS_Z4); pitch = Z4P; c0 = (pn - 11) * 256; }
        else if (pn < 15) { base = (bf16*)(ws + WS_Z5); pitch = Z5P; c0 = (pn - 13) * 256; }
        else { base = (bf16*)(ws + WS_Z6); pitch = Z6P; c0 = (pn - 15) * 256; }
        const int row0 = u.pm * 256 + wr * 64 + fr;
        if (pn < 2 || pn == 9 || pn == 10) {
            const float* CS = (const float*)(ws + SM_CS);
            const int d1 = 32 * (wc & 1) + 8 * fq, colb = c0 + (wc >> 1) * 128 + d1; const bool lat = u.pm < 128;
#pragma unroll
            for (int ai = 0; ai < 2; ++ai)
#pragma unroll
                for (int m = 0; m < 4; ++m) { const int row = row0 + ai * 128 + m * 16; const int t = row & (T - 1);
                    const int pos = d1 < 32 ? (t >> 6) : (t & 63); const float* cp = CS + (size_t)(pos * 32 + (d1 & 31)) * 2;
                    const pg8::f32x4 cs0 = *(const pg8::f32x4*)cp, cs1 = *(const pg8::f32x4*)(cp + 4), cs2 = *(const pg8::f32x4*)(cp + 8), cs3 = *(const pg8::f32x4*)(cp + 12);
                    const float cv[8] = {cs0[0], cs0[2], cs1[0], cs1[2], cs2[0], cs2[2], cs3[0], cs3[2]}, sv[8] = {cs0[1], cs0[3], cs1[1], cs1[3], cs2[1], cs2[3], cs3[1], cs3[3]};
                    float o1[8], o2[8];
#pragma unroll
                    for (int e = 0; e < 8; ++e) { const float x1 = acc[ai][0][m][e >> 2][e & 3] * sc, x2 = acc[ai][1][m][e >> 2][e & 3] * sc;
                        const float c = lat ? cv[e] : 1.f, s = lat ? sv[e] : 0.f; o1[e] = x1 * c - x2 * s; o2[e] = x1 * s + x2 * c; }
                    bf16* rowp = base + (size_t)row * pitch + colb;
                    v4u w1, w2; w1.x = pg8::cvt_pk_bf16(o1[0], o1[1]); w1.y = pg8::cvt_pk_bf16(o1[2], o1[3]); w1.z = pg8::cvt_pk_bf16(o1[4], o1[5]); w1.w = pg8::cvt_pk_bf16(o1[6], o1[7]);
                    w2.x = pg8::cvt_pk_bf16(o2[0], o2[1]); w2.y = pg8::cvt_pk_bf16(o2[2], o2[3]); w2.z = pg8::cvt_pk_bf16(o2[4], o2[5]); w2.w = pg8::cvt_pk_bf16(o2[6], o2[7]);
                    *(v4u*)rowp = w1; *(v4u*)(rowp + 64) = w2; }
            return;
        }
        const int col0 = c0 + wc * 32 + 8 * fq;
#pragma unroll
        for (int ai = 0; ai < 2; ++ai)
#pragma unroll
            for (int m = 0; m < 4; ++m) { bf16* rowp = base + (size_t)(row0 + ai * 128 + m * 16) * pitch + col0;
#pragma unroll
                for (int bj = 0; bj < 2; ++bj) { const pg8::f32x4 v0 = acc[ai][bj][m][0] * sc, v1 = acc[ai][bj][m][1] * sc;
                    v4u w; w.x = pg8::cvt_pk_bf16(v0[0], v0[1]); w.y = pg8::cvt_pk_bf16(v0[2], v0[3]); w.z = pg8::cvt_pk_bf16(v1[0], v1[1]); w.w = pg8::cvt_pk_bf16(v1[2], v1[3]);
                    *(v4u*)(rowp + bj * 128) = w; } }
    }
};

__device__ __forceinline__ void p2_ctx_lora(Frame& F) {
    const bf16* H = (const bf16*)(F.ws + WS_H); const bf16* WinT = (const bf16*)(F.ws + WS_WINT); bf16* Z2 = (bf16*)(F.ws + WS_Z2);
    const int l = F.lane, i = l & 15, g = l >> 4;
    for (int su = F.bid; su < NCTX / 16; su += F.G) {
        const bf16* ap = H + (size_t)(NTOK + 16 * su + i) * 1024 + 8 * g; const bf16* bp = WinT + (size_t)(2048 + 16 * F.wave + i) * 1024 + 8 * g;
        pg8::f32x4 acc = (pg8::f32x4){0.f, 0.f, 0.f, 0.f};
#pragma unroll
        for (int hk = 0; hk < 2; ++hk) {
            pg8::bf16x8 av[16], bv[16];
#pragma unroll
            for (int ks = 0; ks < 16; ++ks) { av[ks] = *(const pg8::bf16x8*)(ap + 32 * (16 * hk + ks)); bv[ks] = *(const pg8::bf16x8*)(bp + 32 * (16 * hk + ks)); }
            __builtin_amdgcn_sched_barrier(0);
#pragma unroll
            for (int ks = 0; ks < 16; ++ks) acc = __builtin_amdgcn_mfma_f32_16x16x32_bf16(av[ks], bv[ks], acc, 0, 0, 0);
            __builtin_amdgcn_sched_barrier(0);
        }
#pragma unroll
        for (int r = 0; r < 4; ++r) Z2[(size_t)(NTOK + 16 * su + 4 * g + r) * Z2P + 1024 + 16 * F.wave + i] = (bf16)f2bf(acc[r]);
    }
}

__device__ __forceinline__ void p3_rope(Frame& F) {
    const int gw = F.bid * NWAVES + F.wave, NGW = F.G * NWAVES;
    const float* CS = (const float*)(F.ws + SM_CS);
    bf16* Z1 = (bf16*)(F.ws + WS_Z1); bf16* Z3 = (bf16*)(F.ws + WS_Z3);
    const int l = F.lane;
    for (int m = gw; m < NTOK; m += NGW) {
        const int t = m % T; const int pos = l < 32 ? t / GRIDW : t % GRIDW, f = l & 31;
        const float c = CS[(pos * 32 + f) * 2], s = CS[(pos * 32 + f) * 2 + 1];
#pragma unroll
        for (int h = 0; h < RH; ++h) {
            bf16* p = Z1 + (size_t)m * Z1P + h * RD + l; float x1 = bf2f(p[0]), x2 = bf2f(p[64]);
            p[0] = (bf16)f2bf(x1 * c - x2 * s); p[64] = (bf16)f2bf(x1 * s + x2 * c);
            bf16* q = Z3 + (size_t)m * Z3P + h * RD + l; x1 = bf2f(q[0]); x2 = bf2f(q[64]);
            q[0] = (bf16)f2bf(x1 * c - x2 * s); q[64] = (bf16)f2bf(x1 * s + x2 * c);
        }
    }
}

typedef short s16x4 __attribute__((ext_vector_type(4)));
__device__ __forceinline__ v4u scale8(const v4u x, float w) {
    v4u o; o.x = pg8::cvt_pk_bf16(bflo(x.x) * w, bfhi(x.x) * w); o.y = pg8::cvt_pk_bf16(bflo(x.y) * w, bfhi(x.y) * w);
    o.z = pg8::cvt_pk_bf16(bflo(x.z) * w, bfhi(x.z) * w); o.w = pg8::cvt_pk_bf16(bflo(x.w) * w, bfhi(x.w) * w); return o; }
__device__ __forceinline__ void p3_retstate(Frame& F) {
    using pg8::bf16x8; using pg8::f32x4;
    constexpr int KS = 288, VS = 160, KB = 64 * KS, VB = 64 * VS;
    const bf16* Z1 = (const bf16*)(F.ws + WS_Z1);
    bf16* RST = (bf16*)((unsigned char*)F.out + OUT_RST);
    const float* ld = F.in[I_RETLD];
    const int l = F.lane, i = l & 15, g = l >> 4, w = F.wave;
    const int kr0 = F.tid >> 4, kch = F.tid & 15, vr = F.tid >> 3, vch = F.tid & 7;
    const int tro = 4 * g + (i >> 2), tco = 8 * (i & 3);
    for (int it = F.bid; it < 256; it += F.G) {
        const int half = (it >> 3) & 1, idx = (it & 7) | ((it >> 4) << 3); const int dir = idx & 1, h = (idx >> 1) & 3, b = idx >> 3;
        const float lg = -__expf(ld[dir * RH + h]);
        const float g64 = __expf(64.f * lg);
        const float wk0 = __expf(lg * (float)(dir == 0 ? 63 - kr0 : kr0)), wk1 = __expf(lg * (float)(dir == 0 ? 31 - kr0 : kr0 + 32));
        f32x4 acc[4];
#pragma unroll
        for (int c = 0; c < 4; ++c) acc[c] = (f32x4){0.f, 0.f, 0.f, 0.f};
        v4u pkA[4][2], pvA[4], pkB[4][2], pvB[4];
#define RS_LOAD(PK, PV, cs) do { _Pragma("unroll") for (int q = 0; q < 4; ++q) { const int s_ = 4 * (cs) + q; \
            const int row0 = s_ < 4 ? NTOK + b * CL + 64 * (dir == 0 ? s_ : 3 - s_) : b * T + 64 * (dir == 0 ? s_ - 4 : 35 - s_); \
            const bf16* rb_ = Z1 + (size_t)row0 * Z1P + h * RD; \
            PK[q][0] = *(const v4u*)(rb_ + (size_t)kr0 * Z1P + kch * 8); PK[q][1] = *(const v4u*)(rb_ + (size_t)(kr0 + 32) * Z1P + kch * 8); \
            PV[q] = *(const v4u*)(rb_ + (size_t)vr * Z1P + 512 + half * 64 + vch * 8); } } while (0)
#define RS_STEP(PK, PV, cs) do { \
            _Pragma("unroll") for (int q = 0; q < 4; ++q) { \
                *(LAS v4u*)(F.lds + q * KB + kr0 * KS + kch * 16) = scale8(PK[q][0], wk0); *(LAS v4u*)(F.lds + q * KB + (kr0 + 32) * KS + kch * 16) = scale8(PK[q][1], wk1); \
                *(LAS v4u*)(F.lds + 4 * KB + q * VB + vr * VS + vch * 16) = PV[q]; } \
            __syncthreads(); \
            if ((cs) + 2 < 8) RS_LOAD(PK, PV, (cs) + 2); \
            _Pragma("unroll") for (int q = 0; q < 4; ++q) { \
                _Pragma("unroll") for (int c = 0; c < 4; ++c) acc[c] = acc[c] * g64; \
                _Pragma("unroll") for (int m = 0; m < 2; ++m) { \
                    const LAS unsigned char* kp = F.lds + q * KB + (tro + 32 * m) * KS + tco + w * 32; \
                    const s16x4 klo = __builtin_amdgcn_ds_read_tr16_b64_v4i16((LAS s16x4*)kp), khi = __builtin_amdgcn_ds_read_tr16_b64_v4i16((LAS s16x4*)(kp + 16 * KS)); \
                    const bf16x8 kf = __builtin_shufflevector(klo, khi, 0, 1, 2, 3, 4, 5, 6, 7); \
                    _Pragma("unroll") for (int c = 0; c < 4; ++c) { \
                        const LAS unsigned char* vp = F.lds + 4 * KB + q * VB + (tro + 32 * m) * VS + tco + c * 32; \
                        const s16x4 vlo = __builtin_amdgcn_ds_read_tr16_b64_v4i16((LAS s16x4*)vp), vhi = __builtin_amdgcn_ds_read_tr16_b64_v4i16((LAS s16x4*)(vp + 16 * VS)); \
                        const bf16x8 vf = __builtin_shufflevector(vlo, vhi, 0, 1, 2, 3, 4, 5, 6, 7); \
                        acc[c] = __builtin_amdgcn_mfma_f32_16x16x32_bf16(vf, kf, acc[c], 0, 0, 0); } } } \
              \
            { const int cidx = dir == 0 ? (cs) : 7 - (cs); \
              bf16* rp = RST + (((size_t)((b * RH + h) * 2 + dir) * 8 + cidx) * 128 + 16 * w + i) * 128 + 64 * half + 4 * g; \
              _Pragma("unroll") for (int c = 0; c < 4; ++c) { v2u ww; ww.x = pk2(acc[c][0], acc[c][1]); ww.y = pk2(acc[c][2], acc[c][3]); *(v2u*)(rp + 16 * c) = ww; } } \
            __syncthreads(); } while (0)
        RS_LOAD(pkA, pvA, 0); RS_LOAD(pkB, pvB, 1);
#pragma unroll 1
        for (int cs = 0; cs < 8; cs += 2) { RS_STEP(pkA, pvA, cs); RS_STEP(pkB, pvB, cs + 1); }
#undef RS_STEP
#undef RS_LOAD
    }
}

__device__ __forceinline__ void p4_retention(Frame& F) {
    using pg8::bf16x8; using pg8::f32x4;
    constexpr int KST = 272, VST = 288, KBY = 64 * KST, VBY = 64 * VST, RFO = 2 * KBY + 2 * VBY, RBY = 128 * VST;
    static_assert(RFO + 2 * RBY <= RING_BYTES, "retention LDS");
    const bf16* Z1 = (const bf16*)(F.ws + WS_Z1); const bf16* Z3 = (const bf16*)(F.ws + WS_Z3); const bf16* Z4 = (const bf16*)(F.ws + WS_Z4);
    const bf16* RST = (const bf16*)((const unsigned char*)F.out + OUT_RST);
    bf16* ARET = (bf16*)(F.ws + WS_ARET);
    const float* ld = F.in[I_RETLD]; const float* gn = F.in[I_RETGN];
    const int w = F.wave;
    for (int u = F.bid; u < 512; u += F.G) {
        int tv = F.tid; asm volatile("" : "+v"(tv));
        const int l = tv & 63, i = l & 15, g = l >> 4;
        const int kbase = i * KST + g * 16, vbase = (4 * g + (i >> 2)) * VST + 8 * (i & 3);
        const int sr0 = tv >> 4, sch = tv & 15;
        const int x = u & 7, qt = (u >> 3) & 7, yy = u >> 6; const int bh = x + 8 * yy; const int b = bh >> 2, h = bh & 3;
        const float lgf = -__expf(ld[h]), lgb = -__expf(ld[RH + h]);
        const int w0 = qt * 256 + 32 * w, wb = w0 >> 6;
        v4u pk0, pk1, pv0, pv1;
        { const bf16* rb = Z1 + (size_t)(b * T + 256 * qt) * Z1P + h * RD + sch * 8;
          pk0 = *(const v4u*)(rb + (size_t)sr0 * Z1P); pk1 = *(const v4u*)(rb + (size_t)(sr0 + 32) * Z1P);
          pv0 = *(const v4u*)(rb + (size_t)sr0 * Z1P + 512); pv1 = *(const v4u*)(rb + (size_t)(sr0 + 32) * Z1P + 512); }
        { const bf16* rf = RST + (((size_t)(bh * 2) * 8 + qt) * 128) * 128; const bf16* rbk = rf + (size_t)8 * 128 * 128;
          v4u a[4], c[4];
#pragma unroll
          for (int q = 0; q < 4; ++q) { a[q] = *(const v4u*)(rf + (size_t)q * 4096 + (sr0 * 128 + sch * 8)); c[q] = *(const v4u*)(rbk + (size_t)q * 4096 + (sr0 * 128 + sch * 8)); }
          LAS unsigned char* rl = F.lds + RFO + sr0 * VST + sch * 16;
#pragma unroll
          for (int q = 0; q < 4; ++q) { *(LAS v4u*)(rl + q * 32 * VST) = a[q]; *(LAS v4u*)(rl + RBY + q * 32 * VST) = c[q]; } }
        f32x4 OT[2][8];
#pragma unroll
        for (int rt = 0; rt < 2; ++rt)
#pragma unroll
            for (int c = 0; c < 8; ++c) OT[rt][c] = (f32x4){0.f, 0.f, 0.f, 0.f};
        *(LAS v4u*)(F.lds + sr0 * KST + sch * 16) = pk0; *(LAS v4u*)(F.lds + (sr0 + 32) * KST + sch * 16) = pk1;
        *(LAS v4u*)(F.lds + 2 * KBY + sr0 * VST + sch * 16) = pv0; *(LAS v4u*)(F.lds + 2 * KBY + (sr0 + 32) * VST + sch * 16) = pv1;
        __syncthreads();
        {
            bf16x8 Qp[2][4];
#pragma unroll
            for (int rt = 0; rt < 2; ++rt)
#pragma unroll
                for (int m = 0; m < 4; ++m) { const bf16* qp = Z3 + (size_t)(b * T + w0 + 16 * rt + i) * Z3P + h * RD + 32 * m + 4 * g;
                    const v2u a = *(const v2u*)qp, c = *(const v2u*)(qp + 16); pg8::u32x4 t4; t4.x = a.x; t4.y = a.y; t4.z = c.x; t4.w = c.y; Qp[rt][m] = __builtin_bit_cast(bf16x8, t4); }
#pragma unroll
            for (int dd = 0; dd < 2; ++dd) {
                const LAS unsigned char* Rb_ = F.lds + RFO + dd * RBY;
#pragma unroll
                for (int c = 0; c < 8; ++c)
#pragma unroll
                    for (int m = 0; m < 4; ++m) {
                        const s16x4 lo = __builtin_amdgcn_ds_read_tr16_b64_v4i16((LAS s16x4*)(Rb_ + vbase + (32 * m) * VST + c * 32));
                        const s16x4 hi = __builtin_amdgcn_ds_read_tr16_b64_v4i16((LAS s16x4*)(Rb_ + vbase + (32 * m + 16) * VST + c * 32));
                        const bf16x8 vf = __builtin_shufflevector(lo, hi, 0, 1, 2, 3, 4, 5, 6, 7);
                        OT[0][c] = __builtin_amdgcn_mfma_f32_16x16x32_bf16(vf, Qp[0][m], OT[0][c], 0, 0, 0);
                        OT[1][c] = __builtin_amdgcn_mfma_f32_16x16x32_bf16(vf, Qp[1][m], OT[1][c], 0, 0, 0);
                        if (m == 3) __builtin_amdgcn_sched_barrier(0); }
#pragma unroll
                for (int rt = 0; rt < 2; ++rt) { const int tl = 32 * w + 16 * rt + i;
                    const float ef = lgf * (float)(tl + 1), eb = lgb * (float)(256 - tl); const float sc = dd == 0 ? __expf(ef - eb) : __expf(eb);
#pragma unroll
                    for (int c = 0; c < 8; ++c) OT[rt][c] = OT[rt][c] * sc; }
            }
        }
        __builtin_amdgcn_sched_barrier(0);
        bf16x8 Qf[2][4];
#pragma unroll
        for (int rt = 0; rt < 2; ++rt)
#pragma unroll
            for (int s = 0; s < 4; ++s) Qf[rt][s] = *(const bf16x8*)(Z3 + (size_t)(b * T + w0 + 16 * rt + i) * Z3P + h * RD + 32 * s + 8 * g);
        const float cfg = __expf(lgf * (float)(63 - 4 * g)), cbg = __expf(lgb * (float)(4 * g));
        const float e1f = __expf(-lgf), e16f = __expf(-16.f * lgf), e1b = __expf(lgb), e16b = __expf(16.f * lgb);
#pragma unroll 1
        for (int kk = 0; kk < 4; ++kk) {
            const int kt = 4 * qt + kk, cb = kk & 1;
            if (kk + 1 < 4) { const int k2 = kt + 1;
                const bf16* rb = Z1 + (size_t)(b * T + 64 * k2) * Z1P + h * RD + sch * 8;
                pk0 = *(const v4u*)(rb + (size_t)sr0 * Z1P); pk1 = *(const v4u*)(rb + (size_t)(sr0 + 32) * Z1P);
                pv0 = *(const v4u*)(rb + (size_t)sr0 * Z1P + 512); pv1 = *(const v4u*)(rb + (size_t)(sr0 + 32) * Z1P + 512); }
            LAS unsigned char* Kb = F.lds + cb * KBY; LAS unsigned char* Vb = F.lds + 2 * KBY + cb * VBY;
            f32x4 S[2][4];
#pragma unroll
            for (int rt = 0; rt < 2; ++rt)
#pragma unroll
                for (int n = 0; n < 4; ++n) S[rt][n] = (f32x4){0.f, 0.f, 0.f, 0.f};
#pragma unroll
            for (int n = 0; n < 4; ++n)
#pragma unroll
                for (int s = 0; s < 4; ++s) { const bf16x8 kf = *(const LAS bf16x8*)(Kb + kbase + n * 16 * KST + s * 64);
                    S[0][n] = __builtin_amdgcn_mfma_f32_16x16x32_bf16(kf, Qf[0][s], S[0][n], 0, 0, 0);
                    S[1][n] = __builtin_amdgcn_mfma_f32_16x16x32_bf16(kf, Qf[1][s], S[1][n], 0, 0, 0);
                    if (s == 3) __builtin_amdgcn_sched_barrier(0); }
            if (kk + 1 < 4) { const int nb = cb ^ 1;
                *(LAS v4u*)(F.lds + nb * KBY + sr0 * KST + sch * 16) = pk0; *(LAS v4u*)(F.lds + nb * KBY + (sr0 + 32) * KST + sch * 16) = pk1;
                *(LAS v4u*)(F.lds + 2 * KBY + nb * VBY + sr0 * VST + sch * 16) = pv0; *(LAS v4u*)(F.lds + 2 * KBY + nb * VBY + (sr0 + 32) * VST + sch * 16) = pv1; }
            __builtin_amdgcn_sched_barrier(0);
            bf16x8 Pf[2][2];
            if (kt == wb) {
#pragma unroll
                for (int rt = 0; rt < 2; ++rt) { const int t = w0 + 16 * rt + i;
#pragma unroll
                    for (int n = 0; n < 4; ++n)
#pragma unroll
                        for (int r = 0; r < 4; ++r) { const int dist = t - (64 * kt + 16 * n + 4 * g + r);
                            const float wg = dist > 0 ? __expf(lgf * (float)dist) : (dist < 0 ? __expf(lgb * (float)(-dist)) : 2.f); S[rt][n][r] *= wg; } }
            } else {
#pragma unroll
                for (int rt = 0; rt < 2; ++rt) { const int t = w0 + 16 * rt + i; float ra, rb2;
                    if (kt < wb) { ra = __expf(lgf * (float)(t - 64 * kt - 63)); rb2 = 0.f; } else { ra = 0.f; rb2 = __expf(lgb * (float)(64 * kt - t)); }
                    float cnf = ra * cfg, cnb = rb2 * cbg;
#pragma unroll
                    for (int n = 0; n < 4; ++n) { float crf = cnf, crb = cnb;
#pragma unroll
                        for (int r = 0; r < 4; ++r) { S[rt][n][r] *= (crf + crb); crf *= e1f; crb *= e1b; }
                        cnf *= e16f; cnb *= e16b; } }
            }
#pragma unroll
            for (int rt = 0; rt < 2; ++rt)
#pragma unroll
                for (int m = 0; m < 2; ++m) { pg8::u32x4 pw; const f32x4 a = S[rt][2 * m], c2 = S[rt][2 * m + 1];
                    pw.x = pg8::cvt_pk_bf16(a[0], a[1]); pw.y = pg8::cvt_pk_bf16(a[2], a[3]); pw.z = pg8::cvt_pk_bf16(c2[0], c2[1]); pw.w = pg8::cvt_pk_bf16(c2[2], c2[3]);
                    Pf[rt][m] = __builtin_bit_cast(bf16x8, pw); }
#pragma unroll
            for (int c = 0; c < 8; ++c)
#pragma unroll
                for (int m = 0; m < 2; ++m) {
                    const s16x4 lo = __builtin_amdgcn_ds_read_tr16_b64_v4i16((LAS s16x4*)(Vb + vbase + (32 * m) * VST + c * 32));
                    const s16x4 hi = __builtin_amdgcn_ds_read_tr16_b64_v4i16((LAS s16x4*)(Vb + vbase + (32 * m + 16) * VST + c * 32));
                    const bf16x8 vf = __builtin_shufflevector(lo, hi, 0, 1, 2, 3, 4, 5, 6, 7);
                    OT[0][c] = __builtin_amdgcn_mfma_f32_16x16x32_bf16(vf, Pf[0][m], OT[0][c], 0, 0, 0);
                    OT[1][c] = __builtin_amdgcn_mfma_f32_16x16x32_bf16(vf, Pf[1][m], OT[1][c], 0, 0, 0);
                    if (m == 1) __builtin_amdgcn_sched_barrier(0); }
            __syncthreads();
        }
#pragma unroll
        for (int rt = 0; rt < 2; ++rt) {
            float s1 = 0.f;
#pragma unroll
            for (int c = 0; c < 8; ++c) s1 += (OT[rt][c][0] + OT[rt][c][1]) + (OT[rt][c][2] + OT[rt][c][3]);
            s1 = swap16_add(s1, s1); s1 = swap32_add(s1, s1);
            const float mean = s1 * (1.f / RD); float s2 = 0.f;
#pragma unroll
            for (int c = 0; c < 8; ++c) { OT[rt][c] = OT[rt][c] - mean; s2 += (OT[rt][c][0] * OT[rt][c][0] + OT[rt][c][1] * OT[rt][c][1]) + (OT[rt][c][2] * OT[rt][c][2] + OT[rt][c][3] * OT[rt][c][3]); }
            s2 = swap16_add(s2, s2); s2 = swap32_add(s2, s2);
            const float rstd = __builtin_amdgcn_rsqf(s2 * (1.f / RD) + 1e-5f);
            const size_t row = (size_t)(b * T + w0 + 16 * rt + i);
#pragma unroll
            for (int c = 0; c < 8; ++c) { const int col = h * RD + 16 * c + 4 * g;
                const v2u gz = *(const v2u*)(Z4 + row * Z4P + col); const f32x4 gg = *(const f32x4*)(gn + col);
                const f32x4 o = OT[rt][c] * rstd * gg;
                v2u ww; ww.x = pk2(siluf_(bflo(gz.x)) * o[0], siluf_(bfhi(gz.x)) * o[1]); ww.y = pk2(siluf_(bflo(gz.y)) * o[2], siluf_(bfhi(gz.y)) * o[3]);
                *(v2u*)(ARET + row * RW + col) = ww; }
        }
    }
}

__device__ __forceinline__ float shift3(float p, float c, float n, float mu0, float mu1) { return c + mu0 * (p - c) + mu1 * (n - c); }
__device__ __forceinline__ float shifted(const bf16* Z, int pitch, int row, int col, bool hasp, bool hasn, float mu0, float mu1) {
    const float c = bf2f(Z[(size_t)row * pitch + col]);
    const float p = hasp ? bf2f(Z[(size_t)(row - 1) * pitch + col]) : 0.f;
    const float n = hasn ? bf2f(Z[(size_t)(row + 1) * pitch + col]) : 0.f;
    return shift3(p, c, n, mu0, mu1);
}
__device__ __forceinline__ void row_bounds(int row, bool& hasp, bool& hasn) {
    if (row < NTOK) { const int t = row % T; hasp = t > 0; hasn = t < T - 1; } else { const int t = (row - NTOK) % CL; hasp = t > 0; hasn = t < CL - 1; }
}

__device__ __forceinline__ void unpack8(const v4u w, float (&f)[8]) { f[0] = bflo(w.x); f[1] = bfhi(w.x); f[2] = bflo(w.y); f[3] = bfhi(w.y); f[4] = bflo(w.z); f[5] = bfhi(w.z); f[6] = bflo(w.w); f[7] = bfhi(w.w); }
__device__ __forceinline__ void shifted8(const bf16* Z, int pitch, int row, int col0, bool hp, bool hn, const float* mu, int mi0, float (&o)[8]) {
    const v4u zero = (v4u){0u, 0u, 0u, 0u};
    const v4u c = *(const v4u*)(Z + (size_t)row * pitch + col0);
    const v4u px = *(const v4u*)(Z + (size_t)(row - (hp ? 1 : 0)) * pitch + col0), nx = *(const v4u*)(Z + (size_t)(row + (hn ? 1 : 0)) * pitch + col0);
    const v4u p = hp ? px : zero, n = hn ? nx : zero;
    float cf[8], pf[8], nf[8]; unpack8(c, cf); unpack8(p, pf); unpack8(n, nf);
    const f32x4 m0a = *(const f32x4*)(mu + mi0), m0b = *(const f32x4*)(mu + mi0 + 4), m1a = *(const f32x4*)(mu + 1792 + mi0), m1b = *(const f32x4*)(mu + 1792 + mi0 + 4);
#pragma unroll
    for (int e = 0; e < 8; ++e) { const float m0 = e < 4 ? m0a[e & 3] : m0b[e & 3], m1 = e < 4 ? m1a[e & 3] : m1b[e & 3]; o[e] = shift3(pf[e], cf[e], nf[e], m0, m1); }
}
__device__ __forceinline__ pg8::bf16x8 pack8(const float (&f)[8]) { pg8::u32x4 w; w.x = pg8::cvt_pk_bf16(f[0], f[1]); w.y = pg8::cvt_pk_bf16(f[2], f[3]); w.z = pg8::cvt_pk_bf16(f[4], f[5]); w.w = pg8::cvt_pk_bf16(f[6], f[7]); return __builtin_bit_cast(pg8::bf16x8, w); }
struct Sh3 { v4u c, p, n; };
__device__ __forceinline__ void shift_load(Sh3& r, const bf16* Z, int pitch, int row, int col0, bool hp, bool hn) {
    r.c = *(const v4u*)(Z + (size_t)row * pitch + col0);
    r.p = *(const v4u*)(Z + (size_t)(row - (hp ? 1 : 0)) * pitch + col0); r.n = *(const v4u*)(Z + (size_t)(row + (hn ? 1 : 0)) * pitch + col0);
}
__device__ __forceinline__ void shift_apply(const Sh3& r, bool hp, bool hn, const float (&m0)[8], const float (&m1)[8], float (&o)[8]) {
    const v4u zero = (v4u){0u, 0u, 0u, 0u}; const v4u p = hp ? r.p : zero, n = hn ? r.n : zero;
    float cf[8], pf[8], nf[8]; unpack8(r.c, cf); unpack8(p, pf); unpack8(n, nf);
#pragma unroll
    for (int e = 0; e < 8; ++e) o[e] = shift3(pf[e], cf[e], nf[e], m0[e], m1[e]);
}
__device__ __forceinline__ void lds8(const LAS float* q, float (&m)[8]) { const f32x4 a = *(const LAS f32x4*)q, b = *(const LAS f32x4*)(q + 4); m[0] = a[0]; m[1] = a[1]; m[2] = a[2]; m[3] = a[3]; m[4] = b[0]; m[5] = b[1]; m[6] = b[2]; m[7] = b[3]; }
__device__ __forceinline__ void p5_prep(Frame& F) {
    using pg8::bf16x8;
    const int gw = F.bid * NWAVES + F.wave, NGW = F.G * NWAVES;
    const bf16* Z2 = (const bf16*)(F.ws + WS_Z2);
    bf16* WL = (bf16*)(F.ws + WS_WL); bf16* AA = (bf16*)F.out; float* KN = (float*)(F.ws + SM_KN);
    const float* mu = F.in[I_MU]; const float* w0 = F.in[I_W0]; const float* a0 = F.in[I_A0];
    const int l = F.lane, i = l & 15, g = l >> 4;
    const int d = F.bid & 1;
    __syncthreads();
    { const bf16* W2T = (const bf16*)(F.ws + SM_W2T) + (size_t)d * 512 * 64; const bf16* A2T = (const bf16*)(F.ws + SM_A2T) + (size_t)d * 512 * 64;
      v4u tw[8], ta[8];
#pragma unroll
      for (int q = 0; q < 8; ++q) { const int idx = F.tid + NTHR * q, r = idx >> 3, c = idx & 7; tw[q] = *(const v4u*)(W2T + (size_t)r * 64 + c * 8); ta[q] = *(const v4u*)(A2T + (size_t)r * 64 + c * 8); }
#pragma unroll
      for (int q = 0; q < 8; ++q) { const int idx = F.tid + NTHR * q, r = idx >> 3, c = idx & 7; const int slot = (r * 8 + (c ^ ((r >> 1) & 7))) * 16;
          *(LAS v4u*)(F.lds + slot) = tw[q]; *(LAS v4u*)(F.lds + 65536 + slot) = ta[q]; } }
    LAS float* CV5 = (LAS float*)(F.lds + 131072);
    { const int k = F.tid; CV5[k] = w0[d * 512 + k]; CV5[512 + k] = a0[d * 512 + k]; if (k < 128) { CV5[1024 + k] = mu[1024 + k]; CV5[1152 + k] = mu[1792 + 1024 + k]; } }
    {
        float m0[8], m1[8], kk8[8];
#pragma unroll
        for (int e = 0; e < 8; ++e) { m0[e] = mu[8 * l + e]; m1[e] = mu[1792 + 8 * l + e]; kk8[e] = F.in[I_KK][8 * l + e]; }
        for (int row0 = gw; row0 < NROW; row0 += 6 * NGW) {
            Sh3 sh[6]; bool hp[6], hn[6];
#pragma unroll
            for (int u = 0; u < 6; ++u) { const int rw = row0 + u * NGW; const int r = rw < NROW ? rw : row0; row_bounds(r, hp[u], hn[u]); shift_load(sh[u], Z2, Z2P, r, 8 * l, hp[u], hn[u]); }
            __builtin_amdgcn_sched_barrier(0);
#pragma unroll
            for (int u = 0; u < 6; ++u) { const int rw = row0 + u * NGW; float ks[8]; shift_apply(sh[u], hp[u], hn[u], m0, m1, ks);
                float ss = 0.f;
#pragma unroll
                for (int e = 0; e < 8; ++e) { const float v = ks[e] * kk8[e]; ss += v * v; }
                ss = red8(ss);
                if ((l & 7) == 0 && rw < NROW) KN[rw * 8 + (l >> 3)] = __builtin_amdgcn_rsqf(ss + 1e-12f); }
        }
    }
    __syncthreads();
    const int wv = (F.bid >> 1) * NWAVES + F.wave, NWV = (F.G >> 1) * NWAVES;
    for (int task = wv; task < (NROW / 32) * 4; task += NWV) {
        const int tok0 = (task % (NROW / 32)) * 32, ntq = task / (NROW / 32);
        bf16x8 Bw[2][2], Ba[2][2];
        { Sh3 sw[2][2], sa[2][2]; bool hp[2], hn[2];
#pragma unroll
          for (int tl = 0; tl < 2; ++tl) { const int row = tok0 + 16 * tl + i; row_bounds(row, hp[tl], hn[tl]);
#pragma unroll
              for (int ks = 0; ks < 2; ++ks) { shift_load(sw[tl][ks], Z2, Z2P, row, 1024 + 32 * ks + 8 * g, hp[tl], hn[tl]); shift_load(sa[tl][ks], Z2, Z2P, row, 1088 + 32 * ks + 8 * g, hp[tl], hn[tl]); } }
          __builtin_amdgcn_sched_barrier(0);
#pragma unroll
          for (int ks = 0; ks < 2; ++ks) { float m0w[8], m1w[8], m0a[8], m1a[8];
              lds8(CV5 + 1024 + 32 * ks + 8 * g, m0w); lds8(CV5 + 1152 + 32 * ks + 8 * g, m1w); lds8(CV5 + 1024 + 64 + 32 * ks + 8 * g, m0a); lds8(CV5 + 1152 + 64 + 32 * ks + 8 * g, m1a);
#pragma unroll
              for (int tl = 0; tl < 2; ++tl) { float v[8];
                  shift_apply(sw[tl][ks], hp[tl], hn[tl], m0w, m1w, v);
#pragma unroll
                  for (int e = 0; e < 8; ++e) { const float ex = __expf(2.f * fminf(fmaxf(v[e], -15.f), 15.f)); v[e] = (ex - 1.f) * __builtin_amdgcn_rcpf(ex + 1.f); }
                  Bw[tl][ks] = pack8(v);
                  shift_apply(sa[tl][ks], hp[tl], hn[tl], m0a, m1a, v);
                  Ba[tl][ks] = pack8(v); } } }
        const int sw0 = (g ^ ((i >> 1) & 7)) * 16, sw1 = ((4 + g) ^ ((i >> 1) & 7)) * 16;
#pragma unroll 2
        for (int nq = 0; nq < 8; ++nq) { const int nt = 8 * ntq + nq;
            const LAS unsigned char* rp = F.lds + (16 * nt + i) * 128;
            const bf16x8 wf0 = *(const LAS bf16x8*)(rp + sw0), wf1 = *(const LAS bf16x8*)(rp + sw1), af0 = *(const LAS bf16x8*)(rp + 65536 + sw0), af1 = *(const LAS bf16x8*)(rp + 65536 + sw1);
            const int ch0 = 16 * nt + 4 * g;
            const f32x4 w0v = *(const LAS f32x4*)(CV5 + ch0), a0v = *(const LAS f32x4*)(CV5 + 512 + ch0);
#pragma unroll
            for (int tl = 0; tl < 2; ++tl) {
                f32x4 aw = (f32x4){0.f, 0.f, 0.f, 0.f}, aa = (f32x4){0.f, 0.f, 0.f, 0.f};
                aw = __builtin_amdgcn_mfma_f32_16x16x32_bf16(wf0, Bw[tl][0], aw, 0, 0, 0); aw = __builtin_amdgcn_mfma_f32_16x16x32_bf16(wf1, Bw[tl][1], aw, 0, 0, 0);
                aa = __builtin_amdgcn_mfma_f32_16x16x32_bf16(af0, Ba[tl][0], aa, 0, 0, 0); aa = __builtin_amdgcn_mfma_f32_16x16x32_bf16(af1, Ba[tl][1], aa, 0, 0, 0);
                aw = aw + w0v; aa = aa + a0v;
                const size_t o = ((size_t)d * NROW + tok0 + 16 * tl + i) * 512 + ch0;
                v2u ww; ww.x = pk2(-0.6065306597f * sigmoidf_(aw[0]), -0.6065306597f * sigmoidf_(aw[1])); ww.y = pk2(-0.6065306597f * sigmoidf_(aw[2]), -0.6065306597f * sigmoidf_(aw[3]));
                *(v2u*)(WL + o) = ww;
                v2u wa; wa.x = pk2(sigmoidf_(aa[0]), sigmoidf_(aa[1])); wa.y = pk2(sigmoidf_(aa[2]), sigmoidf_(aa[3]));
                *(v2u*)(AA + o) = wa; }
        }
    }
    __syncthreads();
}

__device__ __forceinline__ void scan_rowinfo(int b, int d, int s, int& row, bool& hp, bool& hn, bool& lat) {
    if (s < CL) { const int pos = d == 0 ? s : CL - 1 - s; row = NTOK + b * CL + pos; hp = pos > 0; hn = pos < CL - 1; lat = false; }
    else { const int s2 = s - CL; const int pos = d == 0 ? s2 : T - 1 - s2; row = b * T + pos; hp = pos > 0; hn = pos < T - 1; lat = true; }
}
constexpr int SC_TS = 32;
constexpr int CS_RS64 = 144, CS_RS32 = 80;
constexpr int CS_KKP = 0, CS_KAP = 4608, CS_KDP = 9216, CS_RP = 13824, CS_KAT = 18432, CS_KDT = 23552, CS_VM = 28672, CS_WC = 33792, CS_SET = 34048;
constexpr int CS_S0A = 2 * CS_SET, CS_S0B = CS_S0A + 9216, CS_CT = CS_S0B + 9216, CS_DMT = CS_CT + 4608, CS_A2T = CS_DMT + 2560, CS_B2T = CS_A2T + 2560, CS_RHS = CS_B2T + 2560, CS_SA = CS_RHS + 8704;
constexpr int CS_NSW = 8, CS_SPW = 4;
constexpr int CS_PS = CS_SA + 5120;
constexpr int CS_RAW = CS_PS + 4096;
static_assert(CS_RAW + CS_NSW * 4096 <= RING_BYTES, "chunked scan LDS");
#define CS_BAR() do { asm volatile("s_waitcnt lgkmcnt(0)" ::: "memory"); __builtin_amdgcn_s_barrier(); asm volatile("" ::: "memory"); } while (0)
#define CS_FRAG(base, RS, rbase, k0) (*(const LAS pg8::bf16x8*)((base) + ((rbase) * (RS) + (k0) * 2) + ((RS) == CS_RS64 ? lo64 : lo32)))
struct ScanRaw { float kr[6], vr[6], rr[6], av[4], wl4[4]; };
#define CS_GLDS(gp, lp) __builtin_amdgcn_global_load_lds((const unsigned*)(gp), (LAS unsigned*)(lp), 16, 0, 0)
template <int DIR> __device__ __forceinline__ void cscan_dma(Frame& F, int b, int h, int cidx, float (&knv)[4]) {
    const bf16* Z2 = (const bf16*)(F.ws + WS_Z2); const bf16* Z5 = (const bf16*)(F.ws + WS_Z5);
    const bf16* WL = (const bf16*)(F.ws + WS_WL); const bf16* AA = (const bf16*)F.out; const float* KN = (const float*)(F.ws + SM_KN);
    const int l = F.lane, sw = F.wave, rr = l >> 3, cc = l & 7;
    const bool lat = cidx >= CL / SC_TS;
    const int len = lat ? T : CL, base = lat ? b * T : NTOK + b * CL;
    const int c0 = lat ? cidx * SC_TS - CL : cidx * SC_TS;
    const int s0 = c0 + sw * CS_SPW;
    const int lo = DIR == 0 ? s0 - 1 : len - 1 - s0 - CS_SPW;
    LAS unsigned char* slot = F.lds + CS_RAW + sw * 4096;
    const int p0 = min(max(lo + rr, 0), len - 1);
    const bf16* k0 = Z2 + (size_t)(base + p0) * Z2P + h * 64 + cc * 8;
    const bf16* r0 = Z5 + (size_t)(lat ? base + p0 : 0) * Z5P + h * 64 + cc * 8;
    const size_t arow = ((size_t)DIR * NROW + base + lo + 1 + (rr & 3)) * 512 + h * 64 + cc * 8;
    CS_GLDS(k0, slot); CS_GLDS(k0 + 512, slot + 1024); CS_GLDS(r0, slot + 2048); CS_GLDS((rr < 4 ? AA : WL) + arow, slot + 3072);
    unsigned vzero; asm("v_mov_b32 %0, 0" : "=v"(vzero));
    const float* kp = KN + (size_t)(base + lo) * 8 + h;
#pragma unroll
    for (int jj = 0; jj < CS_SPW; ++jj) { const int q = DIR == 0 ? jj + 1 : CS_SPW - jj; knv[jj] = kp[(unsigned)(q * 8) + vzero]; }
}
template <int DIR> __device__ __forceinline__ void cscan_rawread(Frame& F, int cidx, ScanRaw& R) {
    const int l = F.lane, sw = F.wave;
    const bool lat = cidx >= CL / SC_TS; const int len = lat ? T : CL;
    const int c0 = lat ? cidx * SC_TS - CL : cidx * SC_TS; const int s0 = c0 + sw * CS_SPW;
    const int lo = DIR == 0 ? s0 - 1 : len - 1 - s0 - CS_SPW;
    const bool ok0 = lo >= 0, ok5 = lo + 5 < len;
    const LAS unsigned char* slot = F.lds + CS_RAW + sw * 4096 + l * 2;
#pragma unroll
    for (int q = 0; q < 6; ++q) { const bool ok = q == 0 ? ok0 : (q == 5 ? ok5 : true);
        const float kx = bf2f(*(const LAS bf16*)(slot + q * 128)), vx = bf2f(*(const LAS bf16*)(slot + 1024 + q * 128)), rx = bf2f(*(const LAS bf16*)(slot + 2048 + q * 128));
        R.kr[q] = ok ? kx : 0.f; R.vr[q] = ok ? vx : 0.f; R.rr[q] = (ok && lat) ? rx : 0.f; }
#pragma unroll
    for (int jj = 0; jj < CS_SPW; ++jj) { const int idx = DIR == 0 ? jj : CS_SPW - 1 - jj;
        R.av[jj] = bf2f(*(const LAS bf16*)(slot + 3072 + idx * 128)); R.wl4[jj] = bf2f(*(const LAS bf16*)(slot + 3584 + idx * 128)); }
}
__device__ __forceinline__ void cscan_psum(Frame& F, int cidx) {
    const LAS unsigned char* slot = F.lds + CS_RAW + F.wave * 4096 + 3584 + F.lane * 2;
    float s = 0.f;
#pragma unroll
    for (int jj = 0; jj < CS_SPW; ++jj) s += bf2f(*(const LAS bf16*)(slot + jj * 128));
    *(LAS float*)(F.lds + CS_PS + (((cidx & 1) * CS_NSW + F.wave) * 64 + F.lane) * 4) = s;
}
struct ScanConst { float mk0, mk1, mv0, mv1, mr0, mr1, kkc, kac, rkc; };
template <int DIR> __device__ __forceinline__ void cscan_stage(Frame& F, int b, int h, int cidx, const ScanRaw& R, const float (&knv)[4], const ScanConst& K, LAS unsigned char* set, float& bsval, unsigned& bsidx) {
    const int l = F.lane, sw = F.wave;
    const bool lat = cidx >= CL / SC_TS;
    const int len = lat ? T : CL, base = lat ? b * T : NTOK + b * CL;
    const int c0 = lat ? cidx * SC_TS - CL : cidx * SC_TS;
    const int s0 = c0 + sw * CS_SPW;
    const int lo = DIR == 0 ? s0 - 1 : len - 1 - s0 - CS_SPW;
    const float mk0 = K.mk0, mk1 = K.mk1, mv0 = K.mv0, mv1 = K.mv1, mr0 = K.mr0, mr1 = K.mr1, kkc = K.kkc, kac = K.kac, rkc = K.rkc;
    float cw = 0.f;
#pragma unroll
    for (int q2 = 0; q2 < CS_NSW - 1; ++q2) { const float ps = *(const LAS float*)(F.lds + CS_PS + (((cidx & 1) * CS_NSW + q2) * 64 + l) * 4); cw += (q2 < sw) ? ps : 0.f; }
    float epv = __expf(cw);
    float bsv[CS_SPW]; unsigned tka[CS_SPW], tkd[CS_SPW], tv[CS_SPW];
#pragma unroll
    for (int jj = 0; jj < CS_SPW; ++jj) { const int q = DIR == 0 ? jj + 1 : CS_SPW - jj; const int t = sw * CS_SPW + jj;
        const float ks = shift3(R.kr[q - 1], R.kr[q], R.kr[q + 1], mk0, mk1), vs = shift3(R.vr[q - 1], R.vr[q], R.vr[q + 1], mv0, mv1), rs = shift3(R.rr[q - 1], R.rr[q], R.rr[q + 1], mr0, mr1);
        const float a = R.av[jj];
        const float kkv = ks * kkc * knv[jj], kdir = ks * (1.f + (a - 1.f) * kac), kka = kkv * a;
        bsv[jj] = rs * kdir * rkc;
        const float ekp = epv; cw += R.wl4[jj]; const float ep = __expf(cw), emn = __builtin_amdgcn_rcpf(ep); epv = ep;
        const unsigned pa = pg8::cvt_pk_bf16(kkv * ekp, kka * emn), pb = pg8::cvt_pk_bf16(kdir * emn, rs * ep), pc = pg8::cvt_pk_bf16(vs, 0.f);
        *(LAS bf16*)(set + CS_KKP + t * CS_RS64 + l * 2) = (bf16)(pa & 0xffffu);
        *(LAS bf16*)(set + CS_KAP + t * CS_RS64 + l * 2) = (bf16)(pa >> 16);
        *(LAS bf16*)(set + CS_KDP + t * CS_RS64 + l * 2) = (bf16)(pb & 0xffffu);
        *(LAS bf16*)(set + CS_RP + t * CS_RS64 + l * 2) = (bf16)(pb >> 16);
        tka[jj] = pa >> 16; tkd[jj] = pb & 0xffffu; tv[jj] = pc & 0xffffu;
        __builtin_amdgcn_sched_barrier(0); }
    { v2u w; w.x = tka[0] | (tka[1] << 16); w.y = tka[2] | (tka[3] << 16); *(LAS v2u*)(set + CS_KAT + l * CS_RS32 + sw * 8) = w;
      w.x = tkd[0] | (tkd[1] << 16); w.y = tkd[2] | (tkd[3] << 16); *(LAS v2u*)(set + CS_KDT + l * CS_RS32 + sw * 8) = w;
      w.x = tv[0] | (tv[1] << 16); w.y = tv[2] | (tv[3] << 16); *(LAS v2u*)(set + CS_VM + l * CS_RS32 + sw * 8) = w; }
    if (sw == CS_NSW - 1) *(LAS float*)(set + CS_WC + l * 4) = __expf(cw);
    if (lat) {
        float bv = swap16_add(swap32_add(bsv[0], bsv[2]), swap32_add(bsv[1], bsv[3]));
        bv += dpp_f<0xB1>(bv); bv += dpp_f<0x4E>(bv); bv += dpp_f<0x141>(bv); bv += dpp_f<0x140>(bv);
        const int jl = l >> 4; const int q = DIR == 0 ? jl + 1 : CS_SPW - jl;
        bsval = bv; bsidx = (unsigned)((DIR * NTOK + base + lo + q) * 8 + h); }
}
__device__ __forceinline__ void cs_phase1(LAS unsigned char* L, const LAS unsigned char* set, int w, int il, int g) {
    using pg8::bf16x8;
    const int lo64 = il * CS_RS64 + g * 16, lo32 = il * CS_RS32 + g * 16;
    const int X = w >> 1, mt = w & 1;
    const LAS unsigned char* Lf = set + (X < 2 ? CS_KKP : CS_RP); const LAS unsigned char* Rt = set + ((X & 1) ? CS_KDP : CS_KAP);
    const bf16x8 a0 = CS_FRAG(Lf, CS_RS64, 16 * mt, 0), a1 = CS_FRAG(Lf, CS_RS64, 16 * mt, 32);
#pragma unroll
    for (int nt = 0; nt < 2; ++nt) {
        f32x4 acc = (f32x4){0.f, 0.f, 0.f, 0.f};
        acc = __builtin_amdgcn_mfma_f32_16x16x32_bf16(a0, CS_FRAG(Rt, CS_RS64, 16 * nt, 0), acc, 0, 0, 0);
        acc = __builtin_amdgcn_mfma_f32_16x16x32_bf16(a1, CS_FRAG(Rt, CS_RS64, 16 * nt, 32), acc, 0, 0, 0);
        const int tau = 16 * nt + il;
        const int tsh = X < 2 ? 0 : 1;
        float v[4];
#pragma unroll
        for (int r = 0; r < 4; ++r) v[r] = (tau < 16 * mt + 4 * g + r + tsh) ? acc[r] : 0.f;
        if (X == 0) {
#pragma unroll
            for (int r = 0; r < 4; ++r) *(LAS float*)(L + CS_CT + (16 * mt + 4 * g + r) * 144 + ((tau & 3) * 8 + (tau >> 2)) * 4) = v[r];
        } else { LAS unsigned char* ob = L + (X == 1 ? CS_DMT : (X == 2 ? CS_A2T : CS_B2T)) + (16 * mt + 4 * g) * CS_RS32 + tau * 2;
            const unsigned p01 = pg8::cvt_pk_bf16(v[0], v[1]), p23 = pg8::cvt_pk_bf16(v[2], v[3]);
            *(LAS bf16*)(ob) = (bf16)(p01 & 0xffffu); *(LAS bf16*)(ob + CS_RS32) = (bf16)(p01 >> 16); *(LAS bf16*)(ob + 2 * CS_RS32) = (bf16)(p23 & 0xffffu); *(LAS bf16*)(ob + 3 * CS_RS32) = (bf16)(p23 >> 16); }
    }
}
__device__ __forceinline__ void cs_phase2(LAS unsigned char* L, const LAS unsigned char* set, const LAS unsigned char* S0, int w, int il, int g) {
    const int lo64 = il * CS_RS64 + g * 16, lo32 = il * CS_RS32 + g * 16;
    const int mt = w >> 1, nt = w & 1;
    f32x4 acc = (f32x4){0.f, 0.f, 0.f, 0.f};
    acc = __builtin_amdgcn_mfma_f32_16x16x32_bf16(CS_FRAG(S0, CS_RS64, 16 * mt, 0), CS_FRAG(set + CS_KKP, CS_RS64, 16 * nt, 0), acc, 0, 0, 0);
    acc = __builtin_amdgcn_mfma_f32_16x16x32_bf16(CS_FRAG(S0, CS_RS64, 16 * mt, 32), CS_FRAG(set + CS_KKP, CS_RS64, 16 * nt, 32), acc, 0, 0, 0);
    acc = __builtin_amdgcn_mfma_f32_16x16x32_bf16(CS_FRAG(set + CS_VM, CS_RS32, 16 * mt, 0), CS_FRAG(L + CS_DMT, CS_RS32, 16 * nt, 0), acc, 0, 0, 0);
    *(LAS f32x4*)(L + CS_RHS + (16 * nt + il) * 272 + (16 * mt + 4 * g) * 4) = -acc;
}
template <int DIR> __device__ __forceinline__ void cs_phase4(LAS unsigned char* L, const LAS unsigned char* set, const LAS unsigned char* S0, LAS unsigned char* S0n, f32x4 (&Sacc)[2],
                                                              int w, int il, int g, int c, int b, int h, v2u& odv, unsigned& odo) {
    using pg8::bf16x8;
    const int lo64 = il * CS_RS64 + g * 16, lo32 = il * CS_RS32 + g * 16;
    constexpr int CCH = CL / SC_TS;
    const int mt = w >> 1, nt = w & 1;
    f32x4 acc = (f32x4){0.f, 0.f, 0.f, 0.f};
    acc = __builtin_amdgcn_mfma_f32_16x16x32_bf16(CS_FRAG(S0, CS_RS64, 16 * mt, 0), CS_FRAG(set + CS_RP, CS_RS64, 16 * nt, 0), acc, 0, 0, 0);
    acc = __builtin_amdgcn_mfma_f32_16x16x32_bf16(CS_FRAG(S0, CS_RS64, 16 * mt, 32), CS_FRAG(set + CS_RP, CS_RS64, 16 * nt, 32), acc, 0, 0, 0);
    const bf16x8 saf = CS_FRAG(L + CS_SA, CS_RS32, 16 * mt, 0), vmf = CS_FRAG(set + CS_VM, CS_RS32, 16 * mt, 0);
    acc = __builtin_amdgcn_mfma_f32_16x16x32_bf16(saf, CS_FRAG(L + CS_A2T, CS_RS32, 16 * nt, 0), acc, 0, 0, 0);
    acc = __builtin_amdgcn_mfma_f32_16x16x32_bf16(vmf, CS_FRAG(L + CS_B2T, CS_RS32, 16 * nt, 0), acc, 0, 0, 0);
    if (c >= CCH) { const int sq = (c - CCH) * SC_TS + 16 * nt + il; const int pos = DIR == 0 ? sq : T - 1 - sq;
        odv.x = pk2(acc[0], acc[1]); odv.y = pk2(acc[2], acc[3]); odo = (unsigned)(pos * 512 + h * 64 + 16 * mt + 4 * g); }
#pragma unroll
    for (int q = 0; q < 2; ++q) { const int nj = 2 * (w & 1) + q;
        Sacc[q] = __builtin_amdgcn_mfma_f32_16x16x32_bf16(saf, CS_FRAG(set + CS_KAT, CS_RS32, 16 * nj, 0), Sacc[q], 0, 0, 0);
        Sacc[q] = __builtin_amdgcn_mfma_f32_16x16x32_bf16(vmf, CS_FRAG(set + CS_KDT, CS_RS32, 16 * nj, 0), Sacc[q], 0, 0, 0);
        const float wc = *(const LAS float*)(set + CS_WC + (16 * nj + il) * 4);
        Sacc[q] = Sacc[q] * wc;
        { const unsigned p01 = pk2(Sacc[q][0], Sacc[q][1]), p23 = pk2(Sacc[q][2], Sacc[q][3]); LAS unsigned char* sp = S0n + (16 * mt + 4 * g) * CS_RS64 + (16 * nj + il) * 2;
          *(LAS bf16*)(sp) = (bf16)(p01 & 0xffffu); *(LAS bf16*)(sp + CS_RS64) = (bf16)(p01 >> 16); *(LAS bf16*)(sp + 2 * CS_RS64) = (bf16)(p23 & 0xffffu); *(LAS bf16*)(sp + 3 * CS_RS64) = (bf16)(p23 >> 16); } }
}
__device__ __forceinline__ void cs_solve(LAS unsigned char* L, int w, int l) {
    const int ri = l >> 2, kq = l & 3;
    const LAS unsigned char* ctb = L + CS_CT + kq * 32;
    const LAS unsigned char* rhb = L + CS_RHS + (16 * w + ri) * 4;
    float sv[8];
#pragma unroll
    for (int q = 0; q < 8; ++q) sv[q] = 0.f;
    float snew = 0.f;
    f32x4 cA[32], cB[32]; float rh[32];
#define CS_SLOAD(j) do { _Pragma("unroll") for (int t_ = 4 * (j); t_ < 4 * (j) + 4; ++t_) { cA[t_] = *(const LAS f32x4*)(ctb + t_ * 144); if (t_ >= 17) cB[t_] = *(const LAS f32x4*)(ctb + t_ * 144 + 16); \
        rh[t_] = *(const LAS float*)(rhb + t_ * 272); } } while (0)
    CS_SLOAD(0);
#pragma unroll
    for (int j = 0; j < 8; ++j) {
        if (j == 0) CS_SLOAD(1); else if (j == 1) CS_SLOAD(2); else if (j == 2) CS_SLOAD(3); else if (j == 3) CS_SLOAD(4); else if (j == 4) CS_SLOAD(5); else if (j == 5) CS_SLOAD(6); else if (j == 6) CS_SLOAD(7);
        __builtin_amdgcn_sched_barrier(0);
#pragma unroll
        for (int t = 4 * j; t < 4 * j + 4; ++t) {
            float cq[8] = {cA[t][0], cA[t][1], cA[t][2], cA[t][3], 0.f, 0.f, 0.f, 0.f};
            if (t >= 17) { cq[4] = cB[t][0]; cq[5] = cB[t][1]; cq[6] = cB[t][2]; cq[7] = cB[t][3]; }
            float older = 0.f;
#pragma unroll
            for (int q = 0; q < 8; ++q) if (t >= 2 && q <= ((t - 2) >> 2)) older = __builtin_fmaf(sv[q], cq[q], older);
            float acc = older;
            if (t >= 1) { const float cn = (kq == ((t - 1) & 3)) ? cq[(t - 1) >> 2] : 0.f; acc = __builtin_fmaf(snew, cn, older);
                sv[(t - 1) >> 2] = (kq == ((t - 1) & 3)) ? snew : sv[(t - 1) >> 2]; }
            acc += dpp_f<0xB1>(acc); acc += dpp_f<0x4E>(acc);
            snew = rh[t] - acc;
        }
        __builtin_amdgcn_sched_barrier(0);
    }
#undef CS_SLOAD
    sv[7] = (kq == 3) ? snew : sv[7];
#pragma unroll
    for (int q = 0; q < 8; ++q) *(LAS bf16*)(L + CS_SA + (16 * w + ri) * CS_RS32 + (4 * q + kq) * 2) = (bf16)f2bf(sv[q]);
}
template <int DIR, bool SOLVER> __device__ __forceinline__ void cscan_loop(Frame& F, int b, int h) {
    using pg8::bf16x8;
    const int l = F.lane, w = F.wave, il = l & 15, g = l >> 4;
    LAS unsigned char* L = F.lds;
    constexpr int NCH = (CL + T) / SC_TS;
    bf16* OD = (bf16*)(F.ws + (DIR == 0 ? WS_OF : WS_OB));
    f32x4 Sacc[2] = {(f32x4){0.f, 0.f, 0.f, 0.f}, (f32x4){0.f, 0.f, 0.f, 0.f}};
    ScanRaw raw; float knC[4], knN[4];
    ScanConst KC; { const float* mu = F.in[I_MU]; const int ch = h * 64 + l; KC.mk0 = mu[ch]; KC.mk1 = mu[1792 + ch]; KC.mv0 = mu[512 + ch]; KC.mv1 = mu[1792 + 512 + ch]; KC.mr0 = mu[1152 + ch]; KC.mr1 = mu[1792 + 1152 + ch];
      KC.kkc = F.in[I_KK][ch]; KC.kac = F.in[I_KA][ch]; KC.rkc = F.in[I_RK][ch]; }
    cscan_dma<DIR>(F, b, h, 0, knC);
    asm volatile("s_waitcnt vmcnt(0)" ::: "memory");
    cscan_psum(F, 0);
    CS_BAR();
    cscan_rawread<DIR>(F, 0, raw);
    asm volatile("s_waitcnt lgkmcnt(0)" ::: "memory");
    cscan_dma<DIR>(F, b, h, 1, knN);
    float* BS = (float*)(F.ws + SM_BS); bf16* ODb = OD + (size_t)b * T * 512;
    v2u odv = (v2u){0u, 0u}; unsigned odo = 0u; bool odp = false; float bsval = 0.f; unsigned bsidx = 0u; bool bsp = false;
    cscan_stage<DIR>(F, b, h, 0, raw, knC, KC, L, bsval, bsidx);
    CS_BAR();
    for (int c = 0; c < NCH; ++c) {
        LAS unsigned char* set = L + (c & 1) * CS_SET; LAS unsigned char* S0 = L + ((c & 1) ? CS_S0B : CS_S0A); LAS unsigned char* S0n = L + ((c & 1) ? CS_S0A : CS_S0B);
        cs_phase1(L, set, w, il, g);
        CS_BAR();
        cs_phase2(L, set, S0, w, il, g);
        if (c + 1 < NCH) { asm volatile("s_waitcnt vmcnt(0)" ::: "memory"); cscan_psum(F, c + 1); }
        if (odp) *(v2u*)(ODb + odo) = odv;
        if (bsp && (l & 15) == 0) BS[bsidx] = bsval;
        CS_BAR();
        if constexpr (SOLVER) cs_solve(L, w, l);
        bsp = false;
        if (c + 1 < NCH) {
            cscan_rawread<DIR>(F, c + 1, raw);
#pragma unroll
            for (int jj = 0; jj < CS_SPW; ++jj) knC[jj] = knN[jj];
            asm volatile("s_waitcnt lgkmcnt(0)" ::: "memory");
            if (c + 2 < NCH) cscan_dma<DIR>(F, b, h, c + 2, knN);
            cscan_stage<DIR>(F, b, h, c + 1, raw, knC, KC, L + ((c + 1) & 1) * CS_SET, bsval, bsidx);
            bsp = (c + 1) >= CL / SC_TS;
        }
        CS_BAR();
        cs_phase4<DIR>(L, set, S0, S0n, Sacc, w, il, g, c, b, h, odv, odo);
        odp = c >= CL / SC_TS;
        CS_BAR();
    }
    if (odp) *(v2u*)(ODb + odo) = odv;
}
template <int DIR> __device__ __forceinline__ void cscan_body(Frame& F, int b, int h) {
    for (int q = F.tid; q < 9216 / 4; q += NTHR) ((LAS unsigned*)(F.lds + CS_S0A))[q] = 0u;
    if (F.wave >= 4) cscan_loop<DIR, false>(F, b, h); else cscan_loop<DIR, true>(F, b, h);
    asm volatile("s_waitcnt vmcnt(0)" ::: "memory");
}
__device__ __forceinline__ void p6_scan(Frame& F) {
    for (int it = F.bid; it < NB * WH * 2; it += F.G) {
        const int d = it & 1, h = (it >> 1) & 7, b = it >> 4;
        if (d == 0) cscan_body<0>(F, b, h); else cscan_body<1>(F, b, h);
        __syncthreads();
    }
}

struct MpLoads { v2u of[4], ob[4], vc[4], vp[4], vn[4]; float bs0, bs1; };
__device__ __forceinline__ void mp_load(MpLoads& m, const bf16* OF, const bf16* OB, const bf16* Z2, const float* BS, int row, int hh, int g, bool hp, bool hn) {
#pragma unroll
    for (int ntl = 0; ntl < 4; ++ntl) { const int ch0 = 64 * hh + 16 * ntl + 4 * g;
        m.of[ntl] = *(const v2u*)(OF + (size_t)row * 512 + ch0); m.ob[ntl] = *(const v2u*)(OB + (size_t)row * 512 + ch0);
        m.vc[ntl] = *(const v2u*)(Z2 + (size_t)row * Z2P + 512 + ch0);
        m.vp[ntl] = *(const v2u*)(Z2 + (size_t)(row - (hp ? 1 : 0)) * Z2P + 512 + ch0); m.vn[ntl] = *(const v2u*)(Z2 + (size_t)(row + (hn ? 1 : 0)) * Z2P + 512 + ch0); }
    m.bs0 = BS[(size_t)row * 8 + hh]; m.bs1 = BS[((size_t)NTOK + row) * 8 + hh];
}
__device__ __forceinline__ void p7_mergeprep(Frame& F) {
    using pg8::bf16x8;
    const int gw = F.bid * NWAVES + F.wave, NGW = F.G * NWAVES;
    const bf16* Z2 = (const bf16*)(F.ws + WS_Z2);
    const bf16* OF = (const bf16*)(F.ws + WS_OF); const bf16* OB = (const bf16*)(F.ws + WS_OB); const float* BS = (const float*)(F.ws + SM_BS);
    const bf16* G2T = (const bf16*)(F.ws + SM_G2T);
    bf16* ARW = (bf16*)(F.ws + WS_ARW);
    const float* mu = F.in[I_MU]; const float* lng = F.in[I_LNG]; const float* lnb = F.in[I_LNB];
    const int l = F.lane, i = l & 15, g = l >> 4;
    __syncthreads();
    { v4u t16[16];
#pragma unroll
      for (int q = 0; q < 16; ++q) { const int idx = F.tid + NTHR * q; t16[q] = *(const v4u*)(G2T + (size_t)(idx >> 4) * 128 + (idx & 15) * 8); }
#pragma unroll
      for (int q = 0; q < 16; ++q) { const int idx = F.tid + NTHR * q, r = idx >> 4, c = idx & 15; *(LAS v4u*)(F.lds + (r * 16 + (c ^ (r & 15))) * 16) = t16[q]; } }
    LAS float* CV = (LAS float*)(F.lds + 131072);
    { const int k = F.tid; CV[k] = mu[512 + k]; CV[512 + k] = mu[1792 + 512 + k]; CV[1024 + k] = lng[k]; CV[1536 + k] = lnb[k]; if (k < 128) { CV[2048 + k] = mu[1664 + k]; CV[2176 + k] = mu[1792 + 1664 + k]; } }
    __syncthreads();
    for (int task = gw; task < NTOK / 16; task += NGW) {
        const int row = task * 16 + i; bool hp, hn; row_bounds(row, hp, hn);
        bf16x8 Bg[4];
        Sh3 sg[4];
#pragma unroll
        for (int ks = 0; ks < 4; ++ks) shift_load(sg[ks], Z2, Z2P, row, 1152 + 32 * ks + 8 * g, hp, hn);
        MpLoads nx; mp_load(nx, OF, OB, Z2, BS, row, 0, g, hp, hn);
        __builtin_amdgcn_sched_barrier(0);
#pragma unroll
        for (int ks = 0; ks < 4; ++ks) { float v[8], m0g[8], m1g[8]; lds8(CV + 2048 + 32 * ks + 8 * g, m0g); lds8(CV + 2176 + 32 * ks + 8 * g, m1g);
            shift_apply(sg[ks], hp, hn, m0g, m1g, v);
#pragma unroll
            for (int e = 0; e < 8; ++e) v[e] = sigmoidf_(v[e]);
            Bg[ks] = pack8(v); }
#pragma unroll 1
        for (int hh = 0; hh < 8; ++hh) {
            const MpLoads cur = nx;
            if (hh + 1 < 8) mp_load(nx, OF, OB, Z2, BS, row, hh + 1, g, hp, hn);
            f32x4 G[4], oo[4]; float s1 = 0.f;
#pragma unroll
            for (int ntl = 0; ntl < 4; ++ntl) { const int nt = 4 * hh + ntl;
                f32x4 acc = (f32x4){0.f, 0.f, 0.f, 0.f};
#pragma unroll
                for (int ks = 0; ks < 4; ++ks) { const bf16x8 af = *(const LAS bf16x8*)(F.lds + ((16 * nt + i) * 16 + ((4 * ks + g) ^ i)) * 16);
                    acc = __builtin_amdgcn_mfma_f32_16x16x32_bf16(af, Bg[ks], acc, 0, 0, 0); }
                G[ntl] = acc;
                const v2u a = cur.of[ntl], b2 = cur.ob[ntl];
                oo[ntl] = (f32x4){bflo(a.x) + bflo(b2.x), bfhi(a.x) + bfhi(b2.x), bflo(a.y) + bflo(b2.y), bfhi(a.y) + bfhi(b2.y)};
                s1 += (oo[ntl][0] + oo[ntl][1]) + (oo[ntl][2] + oo[ntl][3]); }
            s1 = swap16_add(s1, s1); s1 = swap32_add(s1, s1);
            const float mean = s1 * (1.f / 64.f); float s2 = 0.f;
#pragma unroll
            for (int ntl = 0; ntl < 4; ++ntl) { oo[ntl] = oo[ntl] - mean; s2 += (oo[ntl][0] * oo[ntl][0] + oo[ntl][1] * oo[ntl][1]) + (oo[ntl][2] * oo[ntl][2] + oo[ntl][3] * oo[ntl][3]); }
            s2 = swap16_add(s2, s2); s2 = swap32_add(s2, s2);
            const float rstd = __builtin_amdgcn_rsqf(s2 * (1.f / 64.f) + 64e-5f);
            const float bon = cur.bs0 + cur.bs1;
#pragma unroll
            for (int ntl = 0; ntl < 4; ++ntl) { const int ch0 = 64 * hh + 16 * ntl + 4 * g;
                const v2u zero2 = (v2u){0u, 0u};
                const v2u vc = cur.vc[ntl], vp = hp ? cur.vp[ntl] : zero2, vn = hn ? cur.vn[ntl] : zero2;
                const f32x4 m0 = *(const LAS f32x4*)(CV + ch0), m1 = *(const LAS f32x4*)(CV + 512 + ch0), lg4 = *(const LAS f32x4*)(CV + 1024 + ch0), lb4 = *(const LAS f32x4*)(CV + 1536 + ch0);
                const f32x4 cf = (f32x4){bflo(vc.x), bfhi(vc.x), bflo(vc.y), bfhi(vc.y)}, pf = (f32x4){bflo(vp.x), bfhi(vp.x), bflo(vp.y), bfhi(vp.y)}, nf = (f32x4){bflo(vn.x), bfhi(vn.x), bflo(vn.y), bfhi(vn.y)};
                const f32x4 vs = cf + m0 * (pf - cf) + m1 * (nf - cf);
                const f32x4 y = oo[ntl] * rstd * lg4 + lb4;
                const f32x4 r = (y + vs * bon) * G[ntl];
                v2u ww; ww.x = pk2(r[0], r[1]); ww.y = pk2(r[2], r[3]);
                *(v2u*)(ARW + (size_t)row * 512 + ch0) = ww; }
        }
    }
    __syncthreads();
}

struct SchedDense {
    int nM, nN, G, c, K; const char* A; const char* Bt;
    __device__ __forceinline__ bool next(int i, pg8::Unit& u) const {
        const int L = i * G + c; if (L >= nM * nN) return false;
        const int per = 8 * nN, g = L / per, rem = L % per; u.pn = rem >> 3; u.pm = g * 8 + (rem & 7); return true;
    }
    __device__ __forceinline__ const char* a_base(const pg8::Unit& u) const { return A + (size_t)u.pm * 256 * K * 2; }
    __device__ __forceinline__ const char* b_base(const pg8::Unit& u) const { return Bt + (size_t)u.pn * 256 * K * 2; }
};
template <bool ADD> struct EpiMix {
    bf16* MIX; const bf16* Z6; int goff;
    __device__ __forceinline__ void operator()(const pg8::f32x4 (&acc)[2][2][4][2], const pg8::Unit& u, int wr, int wc, int fr, int fq) const {
        const int row0 = u.pm * 256 + wr * 64 + fr, col0 = u.pn * 256 + wc * 32 + 8 * fq;
#pragma unroll
        for (int ai = 0; ai < 2; ++ai)
#pragma unroll
            for (int m = 0; m < 4; ++m) { const int row = row0 + ai * 128 + m * 16;
#pragma unroll
                for (int bj = 0; bj < 2; ++bj) { const int col = col0 + bj * 128;
                    const v4u gz = *(const v4u*)(Z6 + (size_t)row * Z6P + goff + col);
                    const pg8::f32x4 a0 = acc[ai][bj][m][0], a1 = acc[ai][bj][m][1];
                    float r[8];
                    r[0] = sigmoidf_(bflo(gz.x)) * a0[0]; r[1] = sigmoidf_(bfhi(gz.x)) * a0[1]; r[2] = sigmoidf_(bflo(gz.y)) * a0[2]; r[3] = sigmoidf_(bfhi(gz.y)) * a0[3];
                    r[4] = sigmoidf_(bflo(gz.z)) * a1[0]; r[5] = sigmoidf_(bfhi(gz.z)) * a1[1]; r[6] = sigmoidf_(bflo(gz.w)) * a1[2]; r[7] = sigmoidf_(bfhi(gz.w)) * a1[3];
                    bf16* dst = MIX + (size_t)row * 1024 + col;
                    if (ADD) { const v4u o = *(const v4u*)dst;
                        r[0] += bflo(o.x); r[1] += bfhi(o.x); r[2] += bflo(o.y); r[3] += bfhi(o.y); r[4] += bflo(o.z); r[5] += bfhi(o.z); r[6] += bflo(o.w); r[7] += bfhi(o.w); }
                    v4u w; w.x = pg8::cvt_pk_bf16(r[0], r[1]); w.y = pg8::cvt_pk_bf16(r[2], r[3]); w.z = pg8::cvt_pk_bf16(r[4], r[5]); w.w = pg8::cvt_pk_bf16(r[6], r[7]);
                    *(v4u*)dst = w; } }
    }
};
struct EpiBf16 {
    bf16* O; int ldc;
    __device__ __forceinline__ void operator()(const pg8::f32x4 (&acc)[2][2][4][2], const pg8::Unit& u, int wr, int wc, int fr, int fq) const {
        const int row0 = u.pm * 256 + wr * 64 + fr, col0 = u.pn * 256 + wc * 32 + 8 * fq;
#pragma unroll
        for (int ai = 0; ai < 2; ++ai)
#pragma unroll
            for (int m = 0; m < 4; ++m) { bf16* rowp = O + (size_t)(row0 + ai * 128 + m * 16) * ldc + col0;
#pragma unroll
                for (int bj = 0; bj < 2; ++bj) { const pg8::f32x4 v0 = acc[ai][bj][m][0], v1 = acc[ai][bj][m][1];
                    v4u w; w.x = pg8::cvt_pk_bf16(v0[0], v0[1]); w.y = pg8::cvt_pk_bf16(v0[2], v0[3]); w.z = pg8::cvt_pk_bf16(v1[0], v1[1]); w.w = pg8::cvt_pk_bf16(v1[2], v1[3]);
                    *(v4u*)(rowp + bj * 128) = w; } }
    }
};

__device__ __forceinline__ void p11_rowpass(Frame& F) {
    const int gw = F.bid * NWAVES + F.wave, NGW = F.G * NWAVES;
    {
        LAS float* scr = (LAS float*)(F.lds + F.wave * 16384);
        unsigned char* WGU = F.ws + WS_WGU; unsigned char* WDN = F.ws + WS_WDN;
        constexpr int I_GU = 16 * 64, I_DN = 16 * 32, NIT = NE * (I_GU + I_DN);
#define MOE_ITEM(it, SRC, LDN, SCOL, K0, DST, DROW) do { const int e_ = (it) / (I_GU + I_DN); int r_ = (it) % (I_GU + I_DN); \
        if (r_ < I_GU) { const int kb = r_ / 64, nb = r_ % 64; DROW = 32 * nb; const int j = DROW >> 8, w_ = DROW & 255; \
            SRC = ((w_ < 128) ? F.in[I_WGATE] : F.in[I_WUP]) + (size_t)e_ * 1024 * 1024; SCOL = j * 128 + (w_ & 127); K0 = 64 * kb; DST = WGU + (size_t)e_ * 2048 * 1024; } \
        else { r_ -= I_GU; const int kb = r_ / 32, nb = r_ % 32; DROW = 32 * nb; SRC = F.in[I_WDOWN] + (size_t)e_ * 1024 * 1024; SCOL = 32 * nb; K0 = 64 * kb; DST = WDN + (size_t)e_ * 1024 * 1024; } } while (0)
        f32x4 va[8], vb[8];
        const float* srcA; int scolA, k0A, drowA; unsigned char* dstA;
        int it = gw;
        if (it < NIT) { MOE_ITEM(it, srcA, 0, scolA, k0A, dstA, drowA); transpose_load(va, srcA, 1024, scolA, k0A, F.lane); }
        while (it < NIT) {
            const int it2 = it + NGW; const float* srcB = srcA; int scolB = scolA, k0B = k0A, drowB = drowA; unsigned char* dstB = dstA;
            if (it2 < NIT) { MOE_ITEM(it2, srcB, 0, scolB, k0B, dstB, drowB); transpose_load(vb, srcB, 1024, scolB, k0B, F.lane); }
            transpose_finish_f8(va, 1024, dstA, drowA, k0A, scr, F.lane, F8_WSCALE);
#pragma unroll
            for (int q = 0; q < 8; ++q) va[q] = vb[q];
            srcA = srcB; scolA = scolB; k0A = k0B; drowA = drowB; dstA = dstB; it = it2;
        }
#undef MOE_ITEM
    }
    const float* MOD = (const float*)(F.ws + SM_MOD); const float* ng = F.in[I_NORMG]; const float* wr_ = F.in[I_WROUTER];
    const bf16* YL = (const bf16*)(F.ws + WS_YLAT); bf16* H2 = (bf16*)(F.ws + WS_H2); float* AFF = (float*)(F.ws + SM_AFF);
    LAS float* WRT = (LAS float*)(F.lds);
    __syncthreads();
    { const float* wrt = (const float*)(F.ws + SM_WRT); f32x4 t8[8];
#pragma unroll
      for (int q = 0; q < 8; ++q) t8[q] = *(const f32x4*)(wrt + 4 * (F.tid + NTHR * q));
#pragma unroll
      for (int q = 0; q < 8; ++q) *(LAS f32x4*)(WRT + 4 * (F.tid + NTHR * q)) = t8[q]; }
    __syncthreads();
    const int ln = F.lane;
    for (int r0 = gw * 16; r0 < NTOK; r0 += NGW * 16) {
        const int b = r0 / T, t0 = r0 % T;
        const float* mod = MOD + b * NMODC;
        f32x4 G1[4], N2S[4], SH[4];
#pragma unroll
        for (int j = 0; j < 4; ++j) { const int k = 4 * ln + 256 * j;
            G1[j] = *(const f32x4*)(mod + 2048 + k) * *(const f32x4*)(ng + 1024 + k);
            N2S[j] = *(const f32x4*)(ng + 2048 + k) * (*(const f32x4*)(mod + 4096 + k) + 1.f); SH[j] = *(const f32x4*)(mod + 3072 + k); }
        v2u yn[2][4]; f32x4 xn[2][4];
#pragma unroll
        for (int r = 0; r < 2; ++r)
#pragma unroll
            for (int j = 0; j < 4; ++j) { yn[r][j] = *((const GAS v2u*)(YL + (size_t)(r0 + r) * D) + ln + 64 * j); xn[r][j] = *(const f32x4*)(F.in[I_X] + (size_t)(r0 + r) * D + 4 * ln + 256 * j); }
#pragma unroll 1
        for (int pr = 0; pr < 8; ++pr) {
            const int m = r0 + 2 * pr;
            v2u yc[2][4]; f32x4 x1[2][4];
#pragma unroll
            for (int r = 0; r < 2; ++r)
#pragma unroll
                for (int j = 0; j < 4; ++j) { yc[r][j] = yn[r][j]; x1[r][j] = xn[r][j]; }
            { const int m2 = pr + 1 < 8 ? m + 2 : m;
#pragma unroll
              for (int r = 0; r < 2; ++r)
#pragma unroll
                  for (int j = 0; j < 4; ++j) { yn[r][j] = *((const GAS v2u*)(YL + (size_t)(m2 + r) * D) + ln + 64 * j); xn[r][j] = *(const f32x4*)(F.in[I_X] + (size_t)(m2 + r) * D + 4 * ln + 256 * j); } }
            float rstd[2], rstd2[2];
#pragma unroll
            for (int r = 0; r < 2; ++r) { float ss = 0.f;
#pragma unroll
                for (int j = 0; j < 4; ++j) { const v2u w = yc[r][j]; const float a = bflo(w.x), c = bfhi(w.x), d = bflo(w.y), e = bfhi(w.y); ss += (a * a + c * c) + (d * d + e * e); }
                rstd[r] = __builtin_amdgcn_rsqf(wave_sum(ss) * (1.f / D) + NORM_EPS); }
#pragma unroll
            for (int r = 0; r < 2; ++r) { float s2 = 0.f;
#pragma unroll
                for (int j = 0; j < 4; ++j) { const int k = 4 * ln + 256 * j; const v2u w = yc[r][j];
                    const f32x4 y = (f32x4){bflo(w.x), bfhi(w.x), bflo(w.y), bfhi(w.y)};
                    x1[r][j] = x1[r][j] + G1[j] * (y * rstd[r]);
                    { v2u xw; xw.x = pk2(x1[r][j].x, x1[r][j].y); xw.y = pk2(x1[r][j].z, x1[r][j].w); *(v2u*)((bf16*)(F.out + (size_t)(m + r) * D) + k) = xw; }
                    s2 += (x1[r][j].x * x1[r][j].x + x1[r][j].y * x1[r][j].y) + (x1[r][j].z * x1[r][j].z + x1[r][j].w * x1[r][j].w); }
                rstd2[r] = __builtin_amdgcn_rsqf(wave_sum(s2) * (1.f / D) + NORM_EPS); }
            float lg[2][16];
#pragma unroll
            for (int e = 0; e < 16; ++e) { lg[0][e] = 0.f; lg[1][e] = 0.f; }
#pragma unroll
            for (int j = 0; j < 4; ++j) { const int k = 4 * ln + 256 * j;
                const f32x4 h0 = x1[0][j] * rstd2[0] * N2S[j] + SH[j], h1 = x1[1][j] * rstd2[1] * N2S[j] + SH[j];
                *(unsigned*)((unsigned char*)H2 + (size_t)m * D + k) = f8x4(h0.x, h0.y, h0.z, h0.w);
                *(unsigned*)((unsigned char*)H2 + (size_t)(m + 1) * D + k) = f8x4(h1.x, h1.y, h1.z, h1.w);
#pragma unroll
                for (int e = 0; e < 16; ++e) { const f32x4 wv = *(const LAS f32x4*)(WRT + e * 1024 + k);
                    lg[0][e] = __builtin_fmaf(h0.w, wv.w, __builtin_fmaf(h0.z, wv.z, __builtin_fmaf(h0.y, wv.y, __builtin_fmaf(h0.x, wv.x, lg[0][e]))));
                    lg[1][e] = __builtin_fmaf(h1.w, wv.w, __builtin_fmaf(h1.z, wv.z, __builtin_fmaf(h1.y, wv.y, __builtin_fmaf(h1.x, wv.x, lg[1][e]))));
                    if ((e & 7) == 7) __builtin_amdgcn_sched_barrier(0); } }
            float t2[8];
#pragma unroll
            for (int e = 0; e < 8; ++e) t2[e] = swap16_add(swap32_add(lg[0][e], lg[1][e]), swap32_add(lg[0][e + 8], lg[1][e + 8]));
            const bool b3 = (ln & 8) != 0, b2 = (ln & 4) != 0, b1 = (ln & 2) != 0;
            float t3[4];
#pragma unroll
            for (int i2 = 0; i2 < 4; ++i2) { const float keep = b3 ? t2[i2 + 4] : t2[i2], send = b3 ? t2[i2] : t2[i2 + 4]; t3[i2] = keep + dpp_f<0x128>(send); }
            float t4[2];
#pragma unroll
            for (int i2 = 0; i2 < 2; ++i2) { const float keep = b2 ? t3[i2 + 2] : t3[i2], send = b2 ? t3[i2] : t3[i2 + 2]; t4[i2] = keep + dpp_xor4(send); }
            float lgt; { const float keep = b1 ? t4[1] : t4[0], send = b1 ? t4[0] : t4[1]; lgt = keep + dpp_f<0x4E>(send); }
            lgt += dpp_f<0xB1>(lgt);
            float mx = lgt; mx = fmaxf(mx, dpp_f<0x4E>(mx)); mx = fmaxf(mx, dpp_f<0x141>(mx)); mx = fmaxf(mx, dpp_f<0x140>(mx)); mx = swap16_max(mx);
            const float ex = expf(lgt - mx);
            float se = ex; se += dpp_f<0x4E>(se); se += dpp_f<0x141>(se); se += dpp_f<0x140>(se); se = swap16_add(se, se);
            if ((ln & 1) == 0) AFF[((size_t)(b * NE + ((ln >> 1) & 15))) * T + (t0 + 2 * pr + (ln >> 5))] = ex / se;
        }
    }
}

__device__ __forceinline__ void p12_topk(Frame& F) {
    LAS int* wtot = (LAS int*)(F.lds);
    const float* AFF = (const float*)(F.ws + SM_AFF); int* IDX = (int*)(F.ws + SM_IDX); float* GATE = (float*)(F.ws + SM_GATE); int* SEL = (int*)(F.ws + SM_SEL);
    const int l = F.lane, w = F.wave;
    for (int be = F.bid; be < NB * NE; be += F.G) {
        const float* av = AFF + (size_t)be * T;
        unsigned vb[32];
#pragma unroll
        for (int j = 0; j < 8; ++j) { const v4u x = *(const v4u*)(av + 4 * (l + 64 * j)); vb[4 * j] = x.x; vb[4 * j + 1] = x.y; vb[4 * j + 2] = x.z; vb[4 * j + 3] = x.w; }
        unsigned thr = 0u;
        for (int bit = 30; bit >= 0; --bit) { const unsigned cand = thr | (1u << bit); int c = 0;
#pragma unroll
            for (int q = 0; q < 32; ++q) c += (vb[q] >= cand) ? 1 : 0;
            c = (int)wave_sum_dpp((float)c);
            if (c >= CAP) thr = cand; }
        int cg = 0;
#pragma unroll
        for (int q = 0; q < 32; ++q) cg += (vb[q] > thr) ? 1 : 0;
        const int cnt_gt = (int)wave_sum_dpp((float)cg), need_eq = CAP - cnt_gt;
        const v4u mine = *(const v4u*)(av + 4 * F.tid); const unsigned mv[4] = {mine.x, mine.y, mine.z, mine.w};
        int ngt = 0, neq = 0;
#pragma unroll
        for (int q = 0; q < 4; ++q) { ngt += mv[q] > thr ? 1 : 0; neq += mv[q] == thr ? 1 : 0; }
        int sgt = ngt, seq = neq;
#pragma unroll
        for (int o = 1; o < 64; o <<= 1) { const int a = __shfl_up(sgt, o), b2 = __shfl_up(seq, o); if (l >= o) { sgt += a; seq += b2; } }
        if (l == 63) { wtot[2 * w] = sgt; wtot[2 * w + 1] = seq; }
        __syncthreads();
        int ogt = 0, oeq = 0;
        for (int q = 0; q < w; ++q) { ogt += wtot[2 * q]; oeq += wtot[2 * q + 1]; }
        int rgt = ogt + sgt - ngt, req = oeq + seq - neq;
#pragma unroll
        for (int q = 0; q < 4; ++q) { const int ti = 4 * F.tid + q; int slot = -1;
            if (mv[q] > thr) { slot = rgt; ++rgt; } else if (mv[q] == thr) { if (req < need_eq) slot = cnt_gt + req; ++req; }
            SEL[(size_t)be * T + ti] = slot;
            if (slot >= 0) { IDX[be * CAP + slot] = ti; GATE[be * CAP + slot] = __builtin_bit_cast(float, mv[q]); } }
        __syncthreads();
    }
}

__device__ __forceinline__ void p13_gather(Frame& F) {
    const int gw = F.bid * NWAVES + F.wave, NGW = F.G * NWAVES;
    const int* IDX = (const int*)(F.ws + SM_IDX); const bf16* H2 = (const bf16*)(F.ws + WS_H2); bf16* XG = (bf16*)(F.ws + WS_XG);
    for (int r0 = gw * 4; r0 < NB * NE * CAP; r0 += NGW * 4) {
        int tok[4]; v4u a[4], c[4];
#pragma unroll
        for (int q = 0; q < 4; ++q) tok[q] = IDX[r0 + q];
#pragma unroll
        for (int q = 0; q < 4; ++q) { const int b = (r0 + q) / (NE * CAP); const GAS v4u* src = (const GAS v4u*)(H2 + ((size_t)b * T + tok[q]) * D) + F.lane; a[q] = src[0]; c[q] = src[64]; }
#pragma unroll
        for (int q = 0; q < 4; ++q) { GAS v4u* dst = (GAS v4u*)(XG + (size_t)(r0 + q) * D) + F.lane; dst[0] = a[q]; dst[64] = c[q]; }
    }
}

struct SchedUp {
    int G, c; const char* A; const char* Bt;
    __device__ __forceinline__ bool next(int i, pg8::Unit& u) const {
        const int L = i * G + c; if (L >= 2048) return false;
        const int rnd = L >> 8, cc = L & 255; const int b = cc >> 4, e = 2 * rnd + ((cc & 15) >> 3); u.pm = b * NE + e; u.pn = cc & 7; return true;
    }
    const int* IDX;
    __device__ __forceinline__ const char* a_base(const pg8::Unit&) const { return A; }
    __device__ __forceinline__ const char* a_root() const { return A; }
    __device__ __forceinline__ const char* b_root() const { return Bt; }
    __device__ __forceinline__ unsigned a_off(const pg8::Unit&) const { return 0u; }
    __device__ __forceinline__ unsigned b_off(const pg8::Unit& u) const { return (unsigned)(((u.pm & 15) * 2048 + u.pn * 256) * 1024); }
    __device__ __forceinline__ unsigned a_rowoff(const pg8::Unit& u, int r) const { return (unsigned)(((u.pm >> 4) * T + IDX[u.pm * CAP + r]) * D); }
    __device__ __forceinline__ const char* b_base(const pg8::Unit& u) const { return Bt + ((size_t)(u.pm & 15) * 2048 + (size_t)u.pn * 256) * 1024; }
};
struct EpiUp {
    unsigned char* HID;
    __device__ __forceinline__ void operator()(const pg8::f32x4 (&acc)[2][2][4][2], const pg8::Unit& u, int wr, int wc, int fr, int fq) const {
        const int row0 = u.pm * 256 + wr * 64 + fr, col0 = u.pn * 128 + wc * 32 + 8 * fq;
        constexpr float iw = 1.f / F8_WSCALE, ho = F8_HSCALE / F8_WSCALE;
#pragma unroll
        for (int ai = 0; ai < 2; ++ai)
#pragma unroll
            for (int m = 0; m < 4; ++m) { unsigned char* rowp = HID + (size_t)(row0 + ai * 128 + m * 16) * FF + col0;
                const pg8::f32x4 g0 = acc[ai][0][m][0] * iw, g1 = acc[ai][0][m][1] * iw, u0 = acc[ai][1][m][0] * ho, u1 = acc[ai][1][m][1] * ho;
                v2u w; w.x = f8x4(siluf_(g0[0]) * u0[0], siluf_(g0[1]) * u0[1], siluf_(g0[2]) * u0[2], siluf_(g0[3]) * u0[3]);
                w.y = f8x4(siluf_(g1[0]) * u1[0], siluf_(g1[1]) * u1[1], siluf_(g1[2]) * u1[2], siluf_(g1[3]) * u1[3]);
                *(v2u*)rowp = w; }
    }
};
struct SchedDown {
    int G, c; const char* A; const char* Bt;
    __device__ __forceinline__ bool next(int i, pg8::Unit& u) const {
        const int L = i * G + c; if (L >= 1024) return false;
        const int rnd = L >> 8, cc = L & 255; const int b = cc >> 4, e = 4 * rnd + ((cc & 15) >> 2); u.pm = b * NE + e; u.pn = cc & 3; return true;
    }
    __device__ __forceinline__ const char* a_root() const { return A; }
    __device__ __forceinline__ const char* b_root() const { return Bt; }
    __device__ __forceinline__ unsigned a_off(const pg8::Unit& u) const { return (unsigned)(u.pm * 256 * 1024); }
    __device__ __forceinline__ unsigned b_off(const pg8::Unit& u) const { return (unsigned)(((u.pm & 15) * 1024 + u.pn * 256) * 1024); }
    __device__ __forceinline__ const char* a_base(const pg8::Unit& u) const { return A + (size_t)u.pm * 256 * 1024; }
    __device__ __forceinline__ const char* b_base(const pg8::Unit& u) const { return Bt + ((size_t)(u.pm & 15) * 1024 + (size_t)u.pn * 256) * 1024; }
};
struct EpiDown {
    bf16* Y; const float* GATE;
    __device__ __forceinline__ void operator()(const pg8::f32x4 (&acc)[2][2][4][2], const pg8::Unit& u, int wr, int wc, int fr, int fq) const {
        const int row0 = u.pm * 256 + wr * 64 + fr, col0 = u.pn * 256 + wc * 32 + 8 * fq;
#pragma unroll
        for (int ai = 0; ai < 2; ++ai)
#pragma unroll
            for (int m = 0; m < 4; ++m) { const int row = row0 + ai * 128 + m * 16; const float gt = GATE[row] * (1.f / (F8_WSCALE * F8_HSCALE)); bf16* rowp = Y + (size_t)row * D + col0;
#pragma unroll
                for (int bj = 0; bj < 2; ++bj) { const pg8::f32x4 v0 = acc[ai][bj][m][0] * gt, v1 = acc[ai][bj][m][1] * gt;
                    v4u w; w.x = pg8::cvt_pk_bf16(v0[0], v0[1]); w.y = pg8::cvt_pk_bf16(v0[2], v0[3]); w.z = pg8::cvt_pk_bf16(v1[0], v1[1]); w.w = pg8::cvt_pk_bf16(v1[2], v1[3]);
                    *(v4u*)(rowp + bj * 128) = w; } }
    }
};

__device__ __forceinline__ void p16_final(Frame& F) {
    int ln; asm volatile("v_mbcnt_lo_u32_b32 %0, -1, 0\n\tv_mbcnt_hi_u32_b32 %0, -1, %0" : "=v"(ln));
    const int gw = F.bid * NWAVES + F.wave, NGW = F.G * NWAVES;
    const float* MOD = (const float*)(F.ws + SM_MOD); const float* ng = F.in[I_NORMG];
    const int* SEL = (const int*)(F.ws + SM_SEL); const bf16* Y = (const bf16*)(F.ws + WS_Y);
    const bf16* ZROW = (const bf16*)(F.ws + WS_CTL + 512 * 1024);
    for (int r0 = gw * 16; r0 < NTOK; r0 += NGW * 16) {
        const int b = r0 / T, t0 = r0 % T;
        f32x4 G2N3[4];
#pragma unroll
        for (int j = 0; j < 4; ++j) { const int k = 4 * ln + 256 * j; G2N3[j] = *(const f32x4*)(MOD + b * NMODC + 5120 + k) * *(const f32x4*)(ng + 3072 + k); }
        int yrowv[4]; unsigned long long bm[4];
#pragma unroll
        for (int q = 0; q < 4; ++q) { const int e = ln & 15, i = ln >> 4; const int sv = SEL[(size_t)(b * NE + e) * T + t0 + 4 * q + i];
            yrowv[q] = (b * NE + e) * CAP + sv; bm[q] = __builtin_amdgcn_ballot_w64(sv >= 0); }
        v2u yv[2][4][4]; v2u xv[2][4]; unsigned rem[2];
#define P16_ISSUE(r) do { const int q_ = (r) >> 2, i_ = (r) & 3, bf_ = (r) & 1; unsigned mk_ = (unsigned)(bm[q_] >> (16 * i_)) & 0xffffu; \
            _Pragma("unroll") for (int k_ = 0; k_ < 4; ++k_) { const bf16* src_ = ZROW; \
                if (mk_) { const int e_ = __builtin_ctz(mk_); mk_ &= mk_ - 1u; src_ = Y + (size_t)__builtin_amdgcn_readlane(yrowv[q_], 16 * i_ + e_) * D; } \
                _Pragma("unroll") for (int j = 0; j < 4; ++j) yv[bf_][k_][j] = *((const GAS v2u*)src_ + ln + 64 * j); } \
            rem[bf_] = mk_; \
            _Pragma("unroll") for (int j = 0; j < 4; ++j) xv[bf_][j] = *(const v2u*)((const bf16*)(F.out + (size_t)(r0 + (r)) * D) + 4 * ln + 256 * j); } while (0)
        P16_ISSUE(0);
#pragma unroll
        for (int r = 0; r < 16; ++r) {
            if (r + 1 < 16) P16_ISSUE(r + 1);
            const int bf = r & 1, q = r >> 2, i = r & 3;
            f32x4 a[4];
#pragma unroll
            for (int j = 0; j < 4; ++j) { a[j] = (f32x4){0.f, 0.f, 0.f, 0.f};
#pragma unroll
                for (int k = 0; k < 4; ++k) { const v2u w = yv[bf][k][j]; a[j] += (f32x4){bflo(w.x), bfhi(w.x), bflo(w.y), bfhi(w.y)}; } }
            for (unsigned mk = rem[bf]; mk; mk &= mk - 1u) { const int e = __builtin_ctz(mk);
                const GAS v2u* yp = (const GAS v2u*)(Y + (size_t)__builtin_amdgcn_readlane(yrowv[q], 16 * i + e) * D) + ln;
#pragma unroll
                for (int j = 0; j < 4; ++j) { const v2u w = yp[64 * j]; a[j] += (f32x4){bflo(w.x), bfhi(w.x), bflo(w.y), bfhi(w.y)}; } }
            float ss = 0.f;
#pragma unroll
            for (int j = 0; j < 4; ++j) ss += (a[j].x * a[j].x + a[j].y * a[j].y) + (a[j].z * a[j].z + a[j].w * a[j].w);
            const float rstd = __builtin_amdgcn_rsqf(wave_sum(ss) * (1.f / D) + NORM_EPS);
#pragma unroll
            for (int j = 0; j < 4; ++j) { const v2u xw = xv[bf][j]; *(f32x4*)(F.out + (size_t)(r0 + r) * D + 4 * ln + 256 * j) = (f32x4){bflo(xw.x), bfhi(xw.x), bflo(xw.y), bfhi(xw.y)} + G2N3[j] * (a[j] * rstd); }
        }
#undef P16_ISSUE
    }
}

constexpr int NPHASE = 17;
__global__ void __launch_bounds__(NTHR, 2) mk_fwd(Args args) {
    extern __shared__ __attribute__((aligned(16))) unsigned char lds[];
    Frame F;
    F.lds = (LAS unsigned char*)lds;
    F.tid = threadIdx.x; F.lane = F.tid & 63; F.wave = __builtin_amdgcn_readfirstlane(F.tid >> 6);
    F.G = gridDim.x; F.bid = blockIdx.x;
    F.in = args.in; F.out = args.out; F.ws = args.ws;
    volatile LAS unsigned* MISC = (volatile LAS unsigned*)(F.lds + MISC_OFF);
    for (int u = F.tid; u < (LDS_BYTES - LDSCTL_OFF) / 4; u += NTHR) ((LAS unsigned*)(F.lds + LDSCTL_OFF))[u] = 0u;
    __syncthreads();
    XcdBarrier bar; bar.bar = (unsigned*)(args.ws + WS_CTL) + CW_BAR; bar.x = 0; bar.st = nullptr;
    const int lo = args.ph_lo, hi = args.ph_hi;
    if (hi - lo > 1) bar = xcd_barrier_post((unsigned*)(args.ws + WS_CTL) + CW_BAR, MISC + 8);
#define IN(k) (lo <= (k) && (k) < hi)
#ifndef PROBE_DUP
#define PROBE_DUP 0
#endif
#define DUPN(k) (((PROBE_DUP >> (k)) & 1) ? 2 : 1)
#define SEAM(k) do { if (IN(k) && IN((k) + 1)) xcd_barrier(bar); } while (0)
    unsigned char* ws = args.ws;
    if (IN(0)) { for (int _r = 0; _r < DUPN(0); ++_r) { p0_prologue(F); if (DUPN(0) > 1) __syncthreads(); } } SEAM(0);
    if (IN(1)) { for (int _r = 0; _r < DUPN(1); ++_r) { p1_hnorm(F); if (DUPN(1) > 1) __syncthreads(); } } SEAM(1);
    if (IN(2)) { for (int _r = 0; _r < DUPN(2); ++_r) { SchedIn S{F.G, F.bid, (const char*)(ws + WS_H), (const char*)(ws + WS_WINT)}; EpiZ E{ws}; pg8::gemm_phase(F.lds + RING_OFF, 1024, S, E); p2_ctx_lora(F); if (DUPN(2) > 1) __syncthreads(); } } SEAM(2);
    if (IN(3)) { for (int _r = 0; _r < DUPN(3); ++_r) { p3_retstate(F); if (DUPN(3) > 1) __syncthreads(); } } SEAM(3);
    if (IN(4)) { for (int _r = 0; _r < DUPN(4); ++_r) { p4_retention(F); if (DUPN(4) > 1) __syncthreads(); } }
    if (IN(5)) { for (int _r = 0; _r < DUPN(5); ++_r) { p5_prep(F); if (DUPN(5) > 1) __syncthreads(); } } SEAM(5);
    if (IN(6)) { for (int _r = 0; _r < DUPN(6); ++_r) { p6_scan(F); if (DUPN(6) > 1) __syncthreads(); } } SEAM(6);
    if (IN(7)) { for (int _r = 0; _r < DUPN(7); ++_r) { p7_mergeprep(F); if (DUPN(7) > 1) __syncthreads(); } }
    if (IN(8)) { for (int _r = 0; _r < DUPN(8); ++_r) { SchedDense S{128, 4, F.G, F.bid, 512, (const char*)(ws + WS_ARET), (const char*)(ws + WS_WBRRET)}; EpiMix<false> E{(bf16*)F.out, (const bf16*)(ws + WS_Z6), 0}; pg8::gemm_phase(F.lds + RING_OFF, 512, S, E); if (DUPN(8) > 1) __syncthreads(); } } SEAM(8);
    if (IN(9)) { for (int _r = 0; _r < DUPN(9); ++_r) { SchedDense S{128, 4, F.G, F.bid, 512, (const char*)(ws + WS_ARW), (const char*)(ws + WS_WBRRW)}; EpiMix<true> E{(bf16*)F.out, (const bf16*)(ws + WS_Z6), 1024}; pg8::gemm_phase(F.lds + RING_OFF, 512, S, E); if (DUPN(9) > 1) __syncthreads(); } } SEAM(9);
    if (IN(10)) { for (int _r = 0; _r < DUPN(10); ++_r) { SchedDense S{128, 4, F.G, F.bid, 1024, (const char*)F.out, (const char*)(ws + WS_WOUT)}; EpiBf16 E{(bf16*)(ws + WS_YLAT), 1024}; pg8::gemm_phase(F.lds + RING_OFF, 1024, S, E); if (DUPN(10) > 1) __syncthreads(); } } SEAM(10);
    if (IN(11)) { for (int _r = 0; _r < DUPN(11); ++_r) { p11_rowpass(F); if (DUPN(11) > 1) __syncthreads(); } } SEAM(11);
    if (IN(12)) { for (int _r = 0; _r < DUPN(12); ++_r) { p12_topk(F); if (DUPN(12) > 1) __syncthreads(); } } SEAM(12);
    if (IN(14)) { for (int _r = 0; _r < DUPN(14); ++_r) { SchedUp S{F.G, F.bid, (const char*)(ws + WS_H2), (const char*)(ws + WS_WGU), (const int*)(ws + SM_IDX)}; EpiUp E{ws + WS_HID}; pg8::gemm_phase_f8<EpiUp, SchedUp, true>(F.lds + RING_OFF, 1024, S, E); if (DUPN(14) > 1) __syncthreads(); } } SEAM(14);
    if (IN(15)) { for (int _r = 0; _r < DUPN(15); ++_r) { SchedDown S{F.G, F.bid, (const char*)(ws + WS_HID), (const char*)(ws + WS_WDN)}; EpiDown E{(bf16*)(ws + WS_Y), (const float*)(ws + SM_GATE)}; pg8::gemm_phase_f8(F.lds + RING_OFF, 1024, S, E); if (DUPN(15) > 1) __syncthreads(); } } SEAM(15);
    if (IN(16)) { for (int _r = 0; _r < DUPN(16); ++_r) { p16_final(F); if (DUPN(16) > 1) __syncthreads(); } }
#undef IN
#undef SEAM
}

extern "C" void kernel_launch(void* const* d_in, const int* in_sizes, int n_in, void* d_out, int out_size, void* d_ws, size_t ws_size, hipStream_t stream) {
    static int grid = 0;
    if (grid == 0) {
        if (n_in != 28 || out_size != NTOK * D || ws_size < WS_END) { fprintf(stderr, "kernel_launch: unexpected sizes n_in %d out %d ws %zu\n", n_in, out_size, ws_size); grid = -1; return; }
        int dev = 0, cus = 0;
        if (hipGetDevice(&dev) != hipSuccess || hipDeviceGetAttribute(&cus, hipDeviceAttributeMultiprocessorCount, dev) != hipSuccess) { grid = -1; return; }
        if (hipFuncSetAttribute((const void*)mk_fwd, hipFuncAttributeMaxDynamicSharedMemorySize, LDS_BYTES) != hipSuccess) { fprintf(stderr, "kernel_launch: hipFuncSetAttribute failed\n"); grid = -1; return; }
        int per_cu = 0;
        if (hipOccupancyMaxActiveBlocksPerMultiprocessor(&per_cu, (const void*)mk_fwd, NTHR, LDS_BYTES) != hipSuccess || per_cu < 1) fprintf(stderr, "kernel_launch: occupancy query says %d\n", per_cu);
        (void)hipGetLastError();
        grid = cus;
    }
    if (grid < 0) return;
    (void)hipMemsetAsync((char*)d_ws + WS_CTL, 0, CTL_ZERO_BYTES, stream);
    Args a{};
    for (int i = 0; i < 28; ++i) a.in[i] = (const float*)d_in[i];
    a.out = (float*)d_out; a.ws = (unsigned char*)d_ws;
#if MK_N_LAUNCHES == 1
    a.ph_lo = 0; a.ph_hi = NPHASE; a.li = 0;
    hipLaunchKernelGGL(mk_fwd, dim3(grid), dim3(NTHR), LDS_BYTES, stream, a);
#else
    for (int p = 0; p < NPHASE; ++p) { a.ph_lo = p; a.ph_hi = p + 1; a.li = p; hipLaunchKernelGGL(mk_fwd, dim3(grid), dim3(NTHR), LDS_BYTES, stream, a); }
#endif
}
```

```cpp
#include <hip/hip_runtime.h>
#include <cstdio>
#include <cstdint>

#ifndef MK_N_LAUNCHES
#define MK_N_LAUNCHES 1
#endif

constexpr int D = 1024, NB = 16, T = 2048, CL = 256, GRIDW = 64;
constexpr int RH = 4, RD = 128, RW = 512;
constexpr int WH = 8, WD = 64, WW = 512;
constexpr int NE = 16, FF = 1024, CAP = 2 * T / NE;
constexpr int NTOK = NB * T, NCTX = NB * CL, NROW = NTOK + NCTX;
constexpr int INC = 5888;
constexpr int NMODC = 6 * D;
constexpr float NORM_EPS = 1e-6f;
static_assert(CAP == 256, "cap");

constexpr size_t MiB = 1u << 20;
constexpr size_t WS_CTL = 0, CTL_ZERO_BYTES = 48 * 1024;
constexpr size_t WS_SM = 1 * MiB;
constexpr size_t SM_MOD = WS_SM;
constexpr size_t SM_CS = SM_MOD + 512 * 1024;
constexpr size_t SM_KN = SM_CS + 64 * 1024;
constexpr size_t SM_BS = SM_KN + 1280 * 1024;
constexpr size_t SM_AFF = SM_BS + 2 * MiB;
constexpr size_t SM_IDX = SM_AFF + 2 * MiB;
constexpr size_t SM_GATE = SM_IDX + 256 * 1024;
constexpr size_t SM_SEL = SM_GATE + 256 * 1024;
constexpr size_t SM_W2T = SM_SEL + 2 * MiB;
constexpr size_t SM_A2T = SM_W2T + 128 * 1024;
constexpr size_t SM_G2T = SM_A2T + 128 * 1024;
constexpr size_t SM_WRT = SM_G2T + 128 * 1024;
static_assert(SM_WRT + 64 * 1024 <= 16 * MiB, "small region");
constexpr size_t WS_WBRRET = 16 * MiB, WS_WBRRW = 17 * MiB, WS_WOUT = 18 * MiB;
constexpr size_t WS_Z6 = 20 * MiB, WS_Z4 = 148 * MiB, WS_Z2 = 180 * MiB, WS_Z5 = 270 * MiB, WS_Z1 = 302 * MiB, WS_Z3 = 374 * MiB;
constexpr size_t WS_H = 406 * MiB, WS_WINT = 478 * MiB;
constexpr size_t WS_ARET = 406 * MiB, WS_WL = 438 * MiB, WS_OF = 302 * MiB, WS_OB = 334 * MiB, WS_ARW = 374 * MiB;
constexpr size_t WS_YLAT = 180 * MiB, WS_H2 = 244 * MiB, WS_WGU = 20 * MiB, WS_WDN = 84 * MiB, WS_XG = 308 * MiB, WS_HID = 116 * MiB, WS_Y = 244 * MiB;
constexpr size_t WS_END = 512 * MiB;
constexpr size_t OUT_RST = 72 * MiB;
constexpr int Z1P = 1024, Z2P = 1280, Z3P = 512, Z4P = 512, Z5P = 512, Z6P = 2048;

namespace pg8 {
#define PG8_LAS __attribute__((address_space(3)))
typedef unsigned short bf16_t;
typedef short bf16x8 __attribute__((ext_vector_type(8)));
typedef float f32x4 __attribute__((ext_vector_type(4)));
typedef unsigned u32x4 __attribute__((ext_vector_type(4)));
constexpr int BM = 256, BK = 64, HALF = 128, HTB = HALF * BK * 2, STAGE_BYTES = 8 * HTB;

__host__ __device__ __forceinline__ int lds_byte(int r, int c) { const int st = (r >> 4) * 2 + (c >> 5), rr = r & 15, cc = c & 31, ob = rr * 64 + cc * 2; return st * 1024 + (ob ^ (((ob >> 9) & 1) << 5)); }
__host__ __device__ __forceinline__ void stage_rc(int b, int& R, int& C) { const int st = b / 1024, sb = b % 1024, swz = sb ^ (((sb >> 9) & 1) << 5); R = (st >> 1) * 16 + swz / 64; C = (st & 1) * 32 + (swz % 64) / 2; }
__host__ __device__ __forceinline__ int perm32(int rho) { const int n = rho >> 4, i = rho & 15; return 8 * (i >> 2) + 4 * n + (i & 3); }

struct Unit { int pm, pn; };
typedef __bf16 bf16x2_t __attribute__((ext_vector_type(2)));
typedef float f32x2_t __attribute__((ext_vector_type(2)));
__device__ __forceinline__ unsigned cvt_pk_bf16(float lo, float hi) { const f32x2_t v = {lo, hi}; return __builtin_bit_cast(unsigned, __builtin_convertvector(v, bf16x2_t)); }

template <class Epi, class Sched, bool GATHER = false>
__device__ __forceinline__ void gemm_phase(PG8_LAS unsigned char* lds, const int K, const Sched& S, const Epi& E) {
    const int tid = threadIdx.x, wid = __builtin_amdgcn_readfirstlane(tid >> 6), lane = tid & 63, wr = wid >> 2, wc = wid & 3, fr = lane & 15, fq = lane >> 4;
    const int nt = K / BK;
    unsigned voffA[2], voffB[2];
#pragma unroll
    for (int i = 0; i < 2; ++i) { int R, C; stage_rc(tid * 16 + i * 8192, R, C); const int Rb = (R & ~31) + perm32(R & 31);
        voffA[i] = (unsigned)(R * K + C) * 2u; voffB[i] = (unsigned)(Rb * K + C) * 2u; }
    const size_t kstep = (size_t)(BK * 2);
    const size_t hstep = (size_t)HALF * K * 2;
    const unsigned ldsw = (unsigned)wid * 1024u;
    const int aoff = lds_byte(wr * 64 + fr, fq * 8), boff = lds_byte(wc * 32 + fr, fq * 8);
#define PG8_SA(b, h) (((b) * 2 + (h)) * HTB)
#define PG8_SB(b, h) ((4 + (b) * 2 + (h)) * HTB)
#define PG8_STAGE(bufoff, gbase, voff) do { _Pragma("unroll") for (int _i = 0; _i < 2; ++_i) \
        __builtin_amdgcn_global_load_lds((const unsigned*)((const char*)(gbase) + (voff)[_i]), (PG8_LAS unsigned*)(lds + (bufoff) + ldsw + _i * 8192), 16, 0, 0); } while (0)
#define PG8_LDA(dst, b, h) do { _Pragma("unroll") for (int m = 0; m < 4; ++m) _Pragma("unroll") for (int k = 0; k < 2; ++k) dst[m][k] = *(const PG8_LAS bf16x8*)(lds + PG8_SA(b, h) + aoff + m * 2048 + k * 1024); } while (0)
#define PG8_LDB(dst, b, h) do { _Pragma("unroll") for (int n = 0; n < 2; ++n) _Pragma("unroll") for (int k = 0; k < 2; ++k) dst[n][k] = *(const PG8_LAS bf16x8*)(lds + PG8_SB(b, h) + boff + n * 2048 + k * 1024); } while (0)
#define PG8_MMA(ai, bj, At, Bt) do { __builtin_amdgcn_s_setprio(1); _Pragma("unroll") for (int m = 0; m < 4; ++m) _Pragma("unroll") for (int n = 0; n < 2; ++n) _Pragma("unroll") for (int k = 0; k < 2; ++k) \
        acc[ai][bj][m][n] = __builtin_amdgcn_mfma_f32_16x16x32_bf16(Bt[n][k], At[m][k], acc[ai][bj][m][n], 0, 0, 0); __builtin_amdgcn_s_setprio(0); } while (0)
#define PG8_WAIT_V(n) asm volatile("s_waitcnt vmcnt(" #n ")" ::: "memory")
#define PG8_WAIT_L(n) asm volatile("s_waitcnt lgkmcnt(" #n ")" ::: "memory")
#define PG8_BAR __builtin_amdgcn_s_barrier()
#define PG8_SCHED __builtin_amdgcn_sched_barrier(0)
    Unit cur, nxt; int ui = 0;
    if (!S.next(0, cur)) return;
    f32x4 acc[2][2][4][2];
#pragma unroll
    for (int a = 0; a < 2; ++a)
#pragma unroll
        for (int b = 0; b < 2; ++b)
#pragma unroll
            for (int m = 0; m < 4; ++m)
#pragma unroll
                for (int n = 0; n < 2; ++n) acc[a][b][m][n] = (f32x4){0.f, 0.f, 0.f, 0.f};
    bf16x8 At[4][2], B0[2][2], B1[2][2];
    const char* cA = S.a_base(cur); const char* cB = S.b_base(cur);
    int srow[2], scol[2];
#pragma unroll
    for (int i = 0; i < 2; ++i) stage_rc(tid * 16 + i * 8192, srow[i], scol[i]);
    unsigned cO[2][2], nO[2][2];
    if constexpr (GATHER) {
#pragma unroll
        for (int h = 0; h < 2; ++h)
#pragma unroll
            for (int i = 0; i < 2; ++i) cO[h][i] = S.a_rowoff(cur, h * HALF + srow[i]) + (unsigned)scol[i] * 2u;
    }
#define PG8_STAGE_A(bufoff, gbase, h, OFF) do { if constexpr (GATHER) { _Pragma("unroll") for (int _i = 0; _i < 2; ++_i) \
        __builtin_amdgcn_global_load_lds((const unsigned*)((const char*)(gbase) + (OFF)[h][_i]), (PG8_LAS unsigned*)(lds + (bufoff) + ldsw + _i * 8192), 16, 0, 0); } \
        else { PG8_STAGE(bufoff, (gbase) + (h) * hstep, voffA); } } while (0)
    PG8_STAGE(PG8_SB(0, 0), cB, voffB); PG8_STAGE(PG8_SB(0, 1), cB + hstep, voffB); PG8_STAGE_A(PG8_SA(0, 0), cA, 0, cO); PG8_STAGE_A(PG8_SA(0, 1), cA, 1, cO);
    if (wr == 1) PG8_BAR;
    PG8_WAIT_V(2); PG8_BAR;
    PG8_STAGE(PG8_SB(1, 0), cB + kstep, voffB); PG8_STAGE_A(PG8_SA(1, 0), cA + kstep, 0, cO); PG8_STAGE(PG8_SB(1, 1), cB + hstep + kstep, voffB);
    PG8_WAIT_V(6); PG8_BAR;
    for (;;) {
        const bool has_next = S.next(ui + 1, nxt);
        const char* nA = has_next ? S.a_base(nxt) : cA; const char* nB = has_next ? S.b_base(nxt) : cB;
        if constexpr (GATHER) {
#pragma unroll
            for (int h = 0; h < 2; ++h)
#pragma unroll
                for (int i = 0; i < 2; ++i) nO[h][i] = has_next ? S.a_rowoff(nxt, h * HALF + srow[i]) + (unsigned)scol[i] * 2u : cO[h][i];
        }
        for (int t = 0; t < nt; t += 2) {
            const bool last = (t == nt - 2);
            unsigned xO[2][2];
            if constexpr (GATHER) {
#pragma unroll
                for (int h = 0; h < 2; ++h)
#pragma unroll
                    for (int i = 0; i < 2; ++i) xO[h][i] = last ? nO[h][i] : cO[h][i];
            }
            const char* a1 = cA + (size_t)(t + 1) * kstep;
            const char* a2 = last ? nA : cA + (size_t)(t + 2) * kstep; const char* b2 = last ? nB : cB + (size_t)(t + 2) * kstep;
            const char* a3 = a2 + kstep; const char* b3 = b2 + kstep;
            PG8_LDB(B0, 0, 0); PG8_LDB(B1, 0, 1); PG8_SCHED; PG8_LDA(At, 0, 0); PG8_STAGE_A(PG8_SA(1, 1), a1, 1, cO);
            PG8_WAIT_V(8); PG8_WAIT_L(0); PG8_BAR; PG8_MMA(0, 0, At, B0); PG8_MMA(0, 1, At, B1); PG8_BAR; PG8_SCHED;
            PG8_LDA(At, 0, 1); PG8_STAGE(PG8_SB(0, 0), b2, voffB); PG8_STAGE(PG8_SB(0, 1), b2 + hstep, voffB); PG8_STAGE_A(PG8_SA(0, 0), a2, 0, xO);
            PG8_WAIT_V(8); PG8_WAIT_L(0); PG8_BAR; PG8_MMA(1, 0, At, B0); PG8_MMA(1, 1, At, B1); PG8_BAR; PG8_SCHED;
            PG8_LDB(B0, 1, 0); PG8_LDB(B1, 1, 1); PG8_SCHED; PG8_LDA(At, 1, 0); PG8_STAGE_A(PG8_SA(0, 1), a2, 1, xO);
            PG8_WAIT_V(8); PG8_WAIT_L(0); PG8_BAR; PG8_MMA(0, 0, At, B0); PG8_MMA(0, 1, At, B1); PG8_BAR; PG8_SCHED;
            PG8_LDA(At, 1, 1); PG8_STAGE(PG8_SB(1, 0), b3, voffB); PG8_STAGE(PG8_SB(1, 1), b3 + hstep, voffB); PG8_STAGE_A(PG8_SA(1, 0), a3, 0, xO);
            PG8_WAIT_V(8); PG8_WAIT_L(0); PG8_BAR; PG8_MMA(1, 0, At, B0); PG8_MMA(1, 1, At, B1); PG8_BAR; PG8_SCHED;
        }
        if (wr == 0) PG8_BAR;
        E(acc, cur, wr, wc, fr, fq);
        if (!has_next) break;
#pragma unroll
        for (int a = 0; a < 2; ++a)
#pragma unroll
            for (int b = 0; b < 2; ++b)
#pragma unroll
                for (int m = 0; m < 4; ++m)
#pragma unroll
                    for (int n = 0; n < 2; ++n) acc[a][b][m][n] = (f32x4){0.f, 0.f, 0.f, 0.f};
        cur = nxt; cA = nA; cB = nB; ++ui;
        if constexpr (GATHER) {
#pragma unroll
            for (int h = 0; h < 2; ++h)
#pragma unroll
                for (int i = 0; i < 2; ++i) cO[h][i] = nO[h][i];
        }
        if (wr == 1) PG8_BAR;
    }
    PG8_WAIT_V(0);
    PG8_BAR;
#undef PG8_SA
#undef PG8_SB
#undef PG8_STAGE
#undef PG8_STAGE_A
#undef PG8_LDA
#undef PG8_LDB
#undef PG8_MMA
#undef PG8_WAIT_V
#undef PG8_WAIT_L
#undef PG8_BAR
#undef PG8_SCHED
}
typedef int i32x8 __attribute__((ext_vector_type(8)));
typedef int i32x4 __attribute__((ext_vector_type(4)));
__device__ __forceinline__ i32x8 f8cat(const bf16x8 lo, const bf16x8 hi) { const u32x4 a = __builtin_bit_cast(u32x4, lo), b = __builtin_bit_cast(u32x4, hi);
    i32x8 r; r[0] = (int)a.x; r[1] = (int)a.y; r[2] = (int)a.z; r[3] = (int)a.w; r[4] = (int)b.x; r[5] = (int)b.y; r[6] = (int)b.z; r[7] = (int)b.w; return r; }
template <class Epi, class Sched, bool GATHER = false>
__device__ __forceinline__ void gemm_phase_f8(PG8_LAS unsigned char* lds, const int K  , const Sched& S, const Epi& E) {
    const int tid = threadIdx.x, wid = __builtin_amdgcn_readfirstlane(tid >> 6), lane = tid & 63, wr = wid >> 2, wc = wid & 3, fr = lane & 15, fq = lane >> 4;
    const int nt = K / 128;
    unsigned voffA[2], voffB[2];
#pragma unroll
    for (int i = 0; i < 2; ++i) { int R, C; stage_rc(tid * 16 + i * 8192, R, C); const int Rb = (R & ~31) + perm32(R & 31);
        voffA[i] = (unsigned)(R * K + C * 2); voffB[i] = (unsigned)(Rb * K + C * 2); }
    const unsigned kstep = 128u;
    const unsigned hstep = (unsigned)(HALF * K);
    const __amdgpu_buffer_rsrc_t rsA = __builtin_amdgcn_make_buffer_rsrc((void*)S.a_root(), 0, 0x7fffffff, 0x00020000), rsB = __builtin_amdgcn_make_buffer_rsrc((void*)S.b_root(), 0, 0x7fffffff, 0x00020000);
    const unsigned ldsw = (unsigned)wid * 1024u;
    const int aoff0 = lds_byte(wr * 64 + fr, fq * 16), boff0 = lds_byte(wc * 32 + fr, fq * 16);
#define PG8_SA(b, h) (((b) * 2 + (h)) * HTB)
#define PG8_SB(b, h) ((4 + (b) * 2 + (h)) * HTB)
#define PG8_STAGE(bufoff, gbase, voff) do { _Pragma("unroll") for (int _i = 0; _i < 2; ++_i) \
        __builtin_amdgcn_raw_ptr_buffer_load_lds(rsB, (PG8_LAS void*)(lds + (bufoff) + ldsw + _i * 8192), 16, (voff)[_i], (gbase), 0, 0); } while (0)
#define PG8_LDA(dst, b, h) do { _Pragma("unroll") for (int m = 0; m < 4; ++m) dst[m] = __builtin_shufflevector(*(const PG8_LAS i32x4*)(lds + PG8_SA(b, h) + aoff0 + m * 2048), *(const PG8_LAS i32x4*)(lds + PG8_SA(b, h) + aoff0 + 16 + m * 2048), 0, 1, 2, 3, 4, 5, 6, 7); } while (0)
#define PG8_LDB(dst, b, h) do { _Pragma("unroll") for (int n = 0; n < 2; ++n) dst[n] = __builtin_shufflevector(*(const PG8_LAS i32x4*)(lds + PG8_SB(b, h) + boff0 + n * 2048), *(const PG8_LAS i32x4*)(lds + PG8_SB(b, h) + boff0 + 16 + n * 2048), 0, 1, 2, 3, 4, 5, 6, 7); } while (0)
#define PG8_MMA(ai, bj, At, Bt) do { __builtin_amdgcn_s_setprio(1); _Pragma("unroll") for (int m = 0; m < 4; ++m) _Pragma("unroll") for (int n = 0; n < 2; ++n) \
        acc[ai][bj][m][n] = __builtin_amdgcn_mfma_scale_f32_16x16x128_f8f6f4(Bt[n], At[m], acc[ai][bj][m][n], 0, 0, 0, 0x7F7F7F7F, 0, 0x7F7F7F7F); __builtin_amdgcn_s_setprio(0); } while (0)
#define PG8_WAIT_V(n) asm volatile("s_waitcnt vmcnt(" #n ")" ::: "memory")
#define PG8_WAIT_L(n) asm volatile("s_waitcnt lgkmcnt(" #n ")" ::: "memory")
#define PG8_BAR __builtin_amdgcn_s_barrier()
#define PG8_SCHED __builtin_amdgcn_sched_barrier(0)
    Unit cur, nxt; int ui = 0;
    if (!S.next(0, cur)) return;
    f32x4 acc[2][2][4][2];
#pragma unroll
    for (int a = 0; a < 2; ++a)
#pragma unroll
        for (int b = 0; b < 2; ++b)
#pragma unroll
            for (int m = 0; m < 4; ++m)
#pragma unroll
                for (int n = 0; n < 2; ++n) acc[a][b][m][n] = (f32x4){0.f, 0.f, 0.f, 0.f};
    i32x8 At[4], B0[2], B1[2];
    unsigned cA = S.a_off(cur), cB = S.b_off(cur);
    int srow[2], scol[2];
#pragma unroll
    for (int i = 0; i < 2; ++i) stage_rc(tid * 16 + i * 8192, srow[i], scol[i]);
    unsigned cO[2][2];
    if constexpr (GATHER) {
#pragma unroll
        for (int h = 0; h < 2; ++h)
#pragma unroll
            for (int i = 0; i < 2; ++i) cO[h][i] = S.a_rowoff(cur, h * HALF + srow[i]) + (unsigned)scol[i] * 2u;
    }
#define PG8_STAGE_A(bufoff, gbase, h, OFF) do { _Pragma("unroll") for (int _i = 0; _i < 2; ++_i) \
        __builtin_amdgcn_raw_ptr_buffer_load_lds(rsA, (PG8_LAS void*)(lds + (bufoff) + ldsw + _i * 8192), 16, GATHER ? (OFF)[h][_i] : voffA[_i], GATHER ? (gbase) : (gbase) + (h) * hstep, 0, 0); } while (0)
    PG8_STAGE(PG8_SB(0, 0), cB, voffB); PG8_STAGE(PG8_SB(0, 1), cB + hstep, voffB); PG8_STAGE_A(PG8_SA(0, 0), cA, 0, cO); PG8_STAGE_A(PG8_SA(0, 1), cA, 1, cO);
    if (wr == 1) PG8_BAR;
    PG8_WAIT_V(2); PG8_BAR;
    PG8_STAGE(PG8_SB(1, 0), cB + kstep, voffB); PG8_STAGE_A(PG8_SA(1, 0), cA + kstep, 0, cO); PG8_STAGE(PG8_SB(1, 1), cB + hstep + kstep, voffB);
    PG8_WAIT_V(6); PG8_BAR;
    for (;;) {
        const bool has_next = S.next(ui + 1, nxt);
        const unsigned nA = has_next ? S.a_off(nxt) : cA, nB = has_next ? S.b_off(nxt) : cB;
        if constexpr (GATHER) {
            u32x4 pk; pk.x = has_next ? S.a_rowoff(nxt, srow[0]) + (unsigned)scol[0] * 2u : cO[0][0]; pk.y = has_next ? S.a_rowoff(nxt, srow[1]) + (unsigned)scol[1] * 2u : cO[0][1];
            pk.z = has_next ? S.a_rowoff(nxt, HALF + srow[0]) + (unsigned)scol[0] * 2u : cO[1][0]; pk.w = has_next ? S.a_rowoff(nxt, HALF + srow[1]) + (unsigned)scol[1] * 2u : cO[1][1];
            *(PG8_LAS u32x4*)(lds + STAGE_BYTES + tid * 16) = pk;
        }
#pragma unroll 1
        for (int t = 0; t < nt; t += 2) {
            const bool last = (t == nt - 2);
            const unsigned a1 = cA + (unsigned)(t + 1) * kstep;
            const unsigned a2 = last ? nA : cA + (unsigned)(t + 2) * kstep, b2 = last ? nB : cB + (unsigned)(t + 2) * kstep;
            const unsigned a3 = a2 + kstep, b3 = b2 + kstep;
            PG8_LDB(B0, 0, 0); PG8_LDB(B1, 0, 1); PG8_SCHED; PG8_LDA(At, 0, 0); PG8_STAGE_A(PG8_SA(1, 1), a1, 1, cO);
            if constexpr (GATHER) { if (last) {
                const u32x4 nv = *(const PG8_LAS u32x4*)(lds + STAGE_BYTES + tid * 16); cO[0][0] = nv.x; cO[0][1] = nv.y; cO[1][0] = nv.z; cO[1][1] = nv.w; } }
            PG8_WAIT_V(8); PG8_WAIT_L(0); PG8_BAR; PG8_MMA(0, 0, At, B0); PG8_MMA(0, 1, At, B1); PG8_BAR; PG8_SCHED;
            PG8_LDA(At, 0, 1); PG8_STAGE(PG8_SB(0, 0), b2, voffB); PG8_STAGE(PG8_SB(0, 1), b2 + hstep, voffB); PG8_STAGE_A(PG8_SA(0, 0), a2, 0, cO);
            PG8_WAIT_V(8); PG8_WAIT_L(0); PG8_BAR; PG8_MMA(1, 0, At, B0); PG8_MMA(1, 1, At, B1); PG8_BAR; PG8_SCHED;
            PG8_LDB(B0, 1, 0); PG8_LDB(B1, 1, 1); PG8_SCHED; PG8_LDA(At, 1, 0); PG8_STAGE_A(PG8_SA(0, 1), a2, 1, cO);
            PG8_WAIT_V(8); PG8_WAIT_L(0); PG8_BAR; PG8_MMA(0, 0, At, B0); PG8_MMA(0, 1, At, B1); PG8_BAR; PG8_SCHED;
            PG8_LDA(At, 1, 1); PG8_STAGE(PG8_SB(1, 0), b3, voffB); PG8_STAGE(PG8_SB(1, 1), b3 + hstep, voffB); PG8_STAGE_A(PG8_SA(1, 0), a3, 0, cO);
            PG8_WAIT_V(8); PG8_WAIT_L(0); PG8_BAR; PG8_MMA(1, 0, At, B0); PG8_MMA(1, 1, At, B1); PG8_BAR; PG8_SCHED;
        }
        if (wr == 0) PG8_BAR;
        E(acc, cur, wr, wc, fr, fq);
        if (!has_next) break;
#pragma unroll
        for (int a = 0; a < 2; ++a)
#pragma unroll
            for (int b = 0; b < 2; ++b)
#pragma unroll
                for (int m = 0; m < 4; ++m)
#pragma unroll
                    for (int n = 0; n < 2; ++n) acc[a][b][m][n] = (f32x4){0.f, 0.f, 0.f, 0.f};
        cur = nxt; cA = nA; cB = nB; ++ui;
        if (wr == 1) PG8_BAR;
    }
    PG8_WAIT_V(0);
    PG8_BAR;
#undef PG8_SA
#undef PG8_SB
#undef PG8_STAGE
#undef PG8_STAGE_A
#undef PG8_LDA
#undef PG8_LDB
#undef PG8_MMA
#undef PG8_WAIT_V
#undef PG8_WAIT_L
#undef PG8_BAR
#undef PG8_SCHED
}
}

#define GAS __attribute__((address_space(1)))
#define LAS __attribute__((address_space(3)))
typedef unsigned short bf16;
typedef unsigned v4u __attribute__((ext_vector_type(4)));
typedef unsigned v2u __attribute__((ext_vector_type(2)));
typedef float f32x4 __attribute__((ext_vector_type(4)));
typedef GAS unsigned gu32;
#define RLX_AGENT __ATOMIC_RELAXED, __HIP_MEMORY_SCOPE_AGENT
#define LDS_WAIT() asm volatile("s_waitcnt lgkmcnt(0)" ::: "memory")
#define VM_WAIT() asm volatile("s_waitcnt vmcnt(0)" ::: "memory")
__device__ __forceinline__ unsigned f2bf(float f) { unsigned u = __builtin_bit_cast(unsigned, f); return (u + 0x7fffu + ((u >> 16) & 1u)) >> 16; }
__device__ __forceinline__ unsigned pk2(float lo, float hi) { return pg8::cvt_pk_bf16(lo, hi); }
__device__ __forceinline__ float bf2f(unsigned b) { return __builtin_bit_cast(float, b << 16); }
__device__ __forceinline__ float bflo(unsigned w) { return __builtin_bit_cast(float, w << 16); }
__device__ __forceinline__ float bfhi(unsigned w) { return __builtin_bit_cast(float, w & 0xffff0000u); }
template <int CTRL> __device__ __forceinline__ float dpp_f(float v) { return __builtin_bit_cast(float, __builtin_amdgcn_update_dpp(0, __builtin_bit_cast(int, v), CTRL, 0xf, 0xf, true)); }
__device__ __forceinline__ float swap32_add(float a, float b) { const auto r = __builtin_amdgcn_permlane32_swap(__builtin_bit_cast(unsigned, a), __builtin_bit_cast(unsigned, b), false, false);
    return __builtin_bit_cast(float, (unsigned)r[0]) + __builtin_bit_cast(float, (unsigned)r[1]); }
__device__ __forceinline__ float swap16_add(float a, float b) { const auto r = __builtin_amdgcn_permlane16_swap(__builtin_bit_cast(unsigned, a), __builtin_bit_cast(unsigned, b), false, false);
    return __builtin_bit_cast(float, (unsigned)r[0]) + __builtin_bit_cast(float, (unsigned)r[1]); }
__device__ __forceinline__ float swap16_max(float a) { const auto r = __builtin_amdgcn_permlane16_swap(__builtin_bit_cast(unsigned, a), __builtin_bit_cast(unsigned, a), false, false);
    return fmaxf(__builtin_bit_cast(float, (unsigned)r[0]), __builtin_bit_cast(float, (unsigned)r[1])); }
__device__ __forceinline__ float dpp_xor4(float v) {
    const int x = __builtin_bit_cast(int, v); int r = __builtin_amdgcn_update_dpp(0, x, 0x114, 0xf, 0xA, false); r = __builtin_amdgcn_update_dpp(r, x, 0x104, 0xf, 0x5, false); return __builtin_bit_cast(float, r); }
__device__ __forceinline__ float red8(float v) { v += dpp_f<0xB1>(v); v += dpp_f<0x4E>(v); v += dpp_f<0x141>(v); return v; }
__device__ __forceinline__ float wave_sum_dpp(float v) {
    v += dpp_f<0xB1>(v); v += dpp_f<0x4E>(v); v += dpp_f<0x141>(v); v += dpp_f<0x140>(v);
    const int vi = __builtin_bit_cast(int, v);
    return (__builtin_bit_cast(float, __builtin_amdgcn_readlane(vi, 0)) + __builtin_bit_cast(float, __builtin_amdgcn_readlane(vi, 16))) +
           (__builtin_bit_cast(float, __builtin_amdgcn_readlane(vi, 32)) + __builtin_bit_cast(float, __builtin_amdgcn_readlane(vi, 48)));
}
__device__ __forceinline__ float wave_sum(float v) { return wave_sum_dpp(v); }
__device__ __forceinline__ float sigmoidf_(float x) { return __builtin_amdgcn_rcpf(1.f + __expf(-x)); }
__device__ __forceinline__ float siluf_(float x) { return x * __builtin_amdgcn_rcpf(1.f + __expf(-x)); }

#define XB_TMO      128
#define XB_XCNT(j)  (256  + 64 * (j))
#define XB_XSUB(j)  (1280 + 64 * (j))
#define XB_XGEN(j)  (2304 + 64 * (j))
#define XB_TOP      3328
#define XB_TOPGEN   3392
#define XCD_BAR_WORDS 3456
#define XB_SPIN_CAP (1u << 22)
__device__ __forceinline__ unsigned xb_ld(unsigned* p)              { return __hip_atomic_load(p, __ATOMIC_RELAXED, __HIP_MEMORY_SCOPE_AGENT); }
__device__ __forceinline__ unsigned xb_add(unsigned* p, unsigned v) { return __hip_atomic_fetch_add(p, v, __ATOMIC_RELAXED, __HIP_MEMORY_SCOPE_AGENT); }
__device__ __forceinline__ unsigned xb_xcc_id() { return (unsigned)__builtin_amdgcn_s_getreg((3 << 11) | 20) & 0xFu; }
#define XB_SPIN(cond, bar) do { unsigned _sp = 0; while (cond) { __builtin_amdgcn_s_sleep(1); \
    if ((++_sp & 255u) == 0u) { if (xb_ld(&(bar)[XB_TMO])) break; if (_sp > XB_SPIN_CAP) { atomicAdd(&(bar)[XB_TMO], 1u); break; } } } } while (0)
struct XcdBarrier { unsigned* bar; unsigned x; volatile LAS unsigned* st; };
__device__ __forceinline__ XcdBarrier xcd_barrier_post(unsigned* bar, volatile LAS unsigned* st) {
    XcdBarrier b; b.bar = bar; b.x = xb_xcc_id(); b.st = st;
    if (threadIdx.x == 0) (void)xb_add(&bar[XB_XCNT(b.x)], 1u);
    return b;
}
__device__ __forceinline__ void xcd_barrier_complete(unsigned* bar, unsigned x, unsigned& nloc, unsigned& nx) {
    const unsigned G = gridDim.x * gridDim.y * gridDim.z;
    unsigned sum, cnt, mine, sp = 0u;
    for (;;) {
        sum = 0u; cnt = 0u; mine = 0u;
#pragma unroll
        for (unsigned j = 0; j < 16; ++j) { const unsigned c = xb_ld(&bar[XB_XCNT(j)]); sum += c; cnt += (c > 0u) ? 1u : 0u; mine = (j == x) ? c : mine; }
        if (sum == G) break;
        __builtin_amdgcn_s_sleep(1);
        if ((++sp & 255u) == 0u) { if (xb_ld(&bar[XB_TMO])) break; if (sp > XB_SPIN_CAP) { atomicAdd(&bar[XB_TMO], 1u); break; } }
    }
    nloc = mine > 0u ? mine : 1u; nx = cnt > 0u ? cnt : 1u;
}
__device__ __forceinline__ void xcd_barrier(const XcdBarrier& b) {
    asm volatile("s_waitcnt vmcnt(0)" ::: "memory");
    __syncthreads();
    if (threadIdx.x == 0) {
        unsigned* bar = b.bar;
        __builtin_amdgcn_s_waitcnt(0);
        unsigned nloc = b.st[0], nx = b.st[1];
        if (nloc == 0u) { xcd_barrier_complete(bar, b.x, nloc, nx); b.st[0] = nloc; b.st[1] = nx; }
        const unsigned old = xb_add(&bar[XB_XSUB(b.x)], 1u);
        const unsigned gen = old / nloc;
        if (old + 1u == (gen + 1u) * nloc) {
            __builtin_amdgcn_fence(__ATOMIC_RELEASE, "agent");
            asm volatile("s_waitcnt vmcnt(0)" ::: "memory");
            const unsigned og = xb_add(&bar[XB_TOP], 1u);
            const unsigned tg = og / nx;
            if (og + 1u == (tg + 1u) * nx) xb_add(&bar[XB_TOPGEN], 1u);
            else XB_SPIN(xb_ld(&bar[XB_TOPGEN]) == tg, bar);
            __builtin_amdgcn_fence(__ATOMIC_ACQUIRE, "agent");
            xb_add(&bar[XB_XGEN(b.x)], 1u);
            asm volatile("s_waitcnt vmcnt(0)" ::: "memory");
        } else {
            XB_SPIN(xb_ld(&bar[XB_XGEN(b.x)]) == gen, bar);
            __builtin_amdgcn_fence(__ATOMIC_ACQUIRE, "agent");
            asm volatile("s_waitcnt vmcnt(0)" ::: "memory");
        }
    }
    __syncthreads();
}

constexpr int NWAVES = 8, NTHR = 512;
constexpr int RING_OFF = 0, RING_BYTES = 149504;
constexpr int LDSCTL_OFF = RING_BYTES, MISC_OFF = LDSCTL_OFF + 320;
constexpr int LDS_BYTES = 151552;
constexpr int CW_BAR = 4096;

struct Args { const float* in[28]; float* out; unsigned char* ws; int ph_lo, ph_hi, li, pad; };
enum { I_X = 0, I_C, I_CTX, I_CCTX, I_WMOD, I_BMOD, I_NORMG, I_WIN, I_RETLD, I_RETGN, I_MU, I_KK, I_KA, I_RK, I_W0, I_W2, I_A0, I_A2, I_G2, I_LNG, I_LNB,
       I_WBRRET, I_WBRRW, I_WOUT, I_WROUTER, I_WGATE, I_WUP, I_WDOWN };

struct Frame {
    LAS unsigned char* lds;
    int tid, lane, wave, G, bid;
    const float* const* in; float* out; unsigned char* ws;
};

__device__ __forceinline__ void transpose_load(f32x4 (&v)[8], const float* W, int ldn, int src_col0, int k0, int lane) {
#pragma unroll
    for (int i = 0; i < 8; ++i) v[i] = __builtin_nontemporal_load((const f32x4*)(W + (size_t)(k0 + 8 * i + (lane >> 3)) * ldn + src_col0 + 4 * (lane & 7)));
}
__device__ __forceinline__ void transpose_finish(const f32x4 (&v)[8], int K, bf16* WT, int dest_row0, int k0, LAS float* scr, int lane) {
#pragma unroll
    for (int i = 0; i < 8; ++i) { LAS float* d = scr + (8 * i + (lane >> 3)) * 33 + 4 * (lane & 7); d[0] = v[i].x; d[1] = v[i].y; d[2] = v[i].z; d[3] = v[i].w; }
    LDS_WAIT(); asm volatile("" ::: "memory");
    const int c = lane & 7;
#pragma unroll
    for (int j = 0; j < 4; ++j) { const int n = (lane >> 3) + 8 * j; const LAS float* s = scr + (8 * c) * 33 + n;
        v4u o; o.x = pk2(s[0 * 33], s[1 * 33]); o.y = pk2(s[2 * 33], s[3 * 33]); o.z = pk2(s[4 * 33], s[5 * 33]); o.w = pk2(s[6 * 33], s[7 * 33]);
        *(GAS v4u*)(WT + (size_t)(dest_row0 + n) * K + k0 + 8 * c) = o; }
    LDS_WAIT(); asm volatile("" ::: "memory");
}
__device__ __forceinline__ void transpose_item(const float* W, int ldn, int K, bf16* WT, int dest_row0, int src_col0, int k0, LAS float* scr, int lane) {
    f32x4 v[8]; transpose_load(v, W, ldn, src_col0, k0, lane); transpose_finish(v, K, WT, dest_row0, k0, scr, lane);
}
__device__ __forceinline__ unsigned f8x4(float a, float b, float c, float d) { int r = __builtin_amdgcn_cvt_pk_fp8_f32(a, b, 0, false); r = __builtin_amdgcn_cvt_pk_fp8_f32(c, d, r, true); return (unsigned)r; }
__device__ __forceinline__ void transpose_finish_f8(const f32x4 (&v)[8], int Kb, unsigned char* WT8, int dest_row0, int k0, LAS float* scr, int lane, float sc) {
#pragma unroll
    for (int i = 0; i < 8; ++i) { LAS float* d = scr + (8 * i + (lane >> 3)) * 33 + 4 * (lane & 7); d[0] = v[i].x * sc; d[1] = v[i].y * sc; d[2] = v[i].z * sc; d[3] = v[i].w * sc; }
    LDS_WAIT(); asm volatile("" ::: "memory");
    const int c = lane & 3;
#pragma unroll
    for (int j = 0; j < 2; ++j) { const int n = (lane >> 2) + 16 * j; const LAS float* s = scr + (16 * c) * 33 + n;
        v4u o; o.x = f8x4(s[0 * 33], s[1 * 33], s[2 * 33], s[3 * 33]); o.y = f8x4(s[4 * 33], s[5 * 33], s[6 * 33], s[7 * 33]);
        o.z = f8x4(s[8 * 33], s[9 * 33], s[10 * 33], s[11 * 33]); o.w = f8x4(s[12 * 33], s[13 * 33], s[14 * 33], s[15 * 33]);
        *(GAS v4u*)(WT8 + (size_t)(dest_row0 + n) * Kb + k0 + 16 * c) = o; }
    LDS_WAIT(); asm volatile("" ::: "memory");
}
constexpr float F8_WSCALE = 16.f, F8_HSCALE = 4.f;
__device__ __forceinline__ int win_orig_col(int c) {
    int cc = c;
    if (c < 512 || (c >= 2304 && c < 2816)) { const int tb = c & ~255, lc = c & 255; const int half = lc >> 7, hd = (lc & 127) >> 6, d1 = lc & 63; cc = tb + hd * 128 + half * 64 + d1; }
    return cc < 2176 ? cc : (cc < 2304 ? cc + 1536 : (cc < 3840 ? cc - 128 : cc));
}

__device__ __forceinline__ void p0_prologue(Frame& F) {
    LAS float* sil = (LAS float*)(F.lds);
    LAS float* red = (LAS float*)(F.lds + 17 * 1024 * 4);
    const float* cvec = F.in[I_C]; const float* cctx = F.in[I_CCTX]; const float* wmod = F.in[I_WMOD]; const float* bmod = F.in[I_BMOD];
    float* MOD = (float*)(F.ws + SM_MOD);
    { float tv[34];
#pragma unroll
      for (int q = 0; q < 34; ++q) { const int i = F.tid + NTHR * q, r = i >> 10, k = i & 1023; tv[q] = r < 16 ? cvec[r * 1024 + k] : cctx[k]; }
#pragma unroll
      for (int q = 0; q < 34; ++q) sil[F.tid + NTHR * q] = siluf_(tv[q]); }
    __syncthreads();
    for (int it = F.bid; it < NMODC / 24; it += F.G) {
        const int c0 = it * 24, kg = F.tid / 24, col = F.tid % 24;
        float acc[17];
#pragma unroll
        for (int r = 0; r < 17; ++r) acc[r] = 0.f;
        if (kg < 21) {
            for (int k0 = kg; k0 < 1024; k0 += 21 * 7) {
                float wv[7];
#pragma unroll
                for (int q = 0; q < 7; ++q) { const int k = k0 + 21 * q; wv[q] = wmod[(size_t)min(k, 1023) * NMODC + c0 + col]; }
#pragma unroll
                for (int q = 0; q < 7; ++q) { const int k = k0 + 21 * q; const float w = k < 1024 ? wv[q] : 0.f; const int kc = min(k, 1023);
#pragma unroll
                    for (int r = 0; r < 17; ++r) acc[r] += sil[r * 1024 + kc] * w; } }
#pragma unroll
            for (int r = 0; r < 17; ++r) red[(kg * 17 + r) * 24 + col] = acc[r];
        }
        __syncthreads();
        if (F.tid < 17 * 24) { const int r = F.tid / 24, cc = F.tid % 24; float s = bmod[c0 + cc];
            for (int g = 0; g < 21; ++g) s += red[(g * 17 + r) * 24 + cc];
            MOD[r * NMODC + c0 + cc] = s; }
        __syncthreads();
    }
    __syncthreads();
    LAS float* scr = (LAS float*)(F.lds + F.wave * 16384);
    const int gw = F.bid * NWAVES + F.wave, NGW = F.G * NWAVES;
    constexpr int I_IN = 16 * (INC / 32), I_BR = 8 * 32, I_OUT = 16 * 32;
    constexpr int I_LO = 32;
    constexpr int NITEMS = I_IN + 2 * I_BR + I_OUT + 3 * I_LO;
    bf16* WinT = (bf16*)(F.ws + WS_WINT); bf16* WbrRetT = (bf16*)(F.ws + WS_WBRRET); bf16* WbrRwT = (bf16*)(F.ws + WS_WBRRW); bf16* WoutT = (bf16*)(F.ws + WS_WOUT);
    for (int it = gw; it < NITEMS; it += NGW) {
        int r = it;
        if (r < I_IN) { const int kb = r / (INC / 32), nb = r % (INC / 32); transpose_item(F.in[I_WIN], INC, 1024, WinT, 32 * nb, win_orig_col(32 * nb), 64 * kb, scr, F.lane); continue; } r -= I_IN;
        if (r < I_BR) { const int kb = r / 32, nb = r % 32; transpose_item(F.in[I_WBRRET], 1024, 512, WbrRetT, 32 * nb, 32 * nb, 64 * kb, scr, F.lane); continue; } r -= I_BR;
        if (r < I_BR) { const int kb = r / 32, nb = r % 32; transpose_item(F.in[I_WBRRW], 1024, 512, WbrRwT, 32 * nb, 32 * nb, 64 * kb, scr, F.lane); continue; } r -= I_BR;
        if (r < I_OUT) { const int kb = r / 32, nb = r % 32; transpose_item(F.in[I_WOUT], 1024, 1024, WoutT, 32 * nb, 32 * nb, 64 * kb, scr, F.lane); continue; } r -= I_OUT;
        if (r < I_LO) { const int dd = r >> 4, nb = r & 15; transpose_item(F.in[I_W2] + dd * 64 * 512, 512, 64, (bf16*)(F.ws + SM_W2T) + dd * 512 * 64, 32 * nb, 32 * nb, 0, scr, F.lane); continue; } r -= I_LO;
        if (r < I_LO) { const int dd = r >> 4, nb = r & 15; transpose_item(F.in[I_A2] + dd * 64 * 512, 512, 64, (bf16*)(F.ws + SM_A2T) + dd * 512 * 64, 32 * nb, 32 * nb, 0, scr, F.lane); continue; } r -= I_LO;
        { const int kb = r >> 4, nb = r & 15; transpose_item(F.in[I_G2], 512, 128, (bf16*)(F.ws + SM_G2T), 32 * nb, 32 * nb, 64 * kb, scr, F.lane); }
    }
    if (F.bid < 16) { float* WRT = (float*)(F.ws + SM_WRT); const float* wr_ = F.in[I_WROUTER]; for (int k = F.tid; k < 1024; k += NTHR) WRT[F.bid * 1024 + k] = wr_[k * 16 + F.bid]; }
    if (F.bid == 0 && F.tid < 32) {
        const int f = F.tid; float* CS = (float*)(F.ws + SM_CS);
        const float invf = exp2f(-(float)f * (13.287712379549449f / 32.f));
        const double th = (double)invf;
        double sn = 0.0, cs = 0.0, term = 1.0;
        for (int n = 0; n < 24; ++n) { if ((n & 1) == 0) cs += ((n & 2) ? -term : term); else sn += ((n & 2) ? -term : term); term = term * th / (double)(n + 1); }
        double c = 1.0, s = 0.0;
        for (int pos = 0; pos < 64; ++pos) { CS[(pos * 32 + f) * 2] = (float)c; CS[(pos * 32 + f) * 2 + 1] = (float)s; const double c2 = c * cs - s * sn, s2 = s * cs + c * sn; c = c2; s = s2; }
    }
}

__device__ __forceinline__ void p1_hnorm(Frame& F) {
    const int gw = F.bid * NWAVES + F.wave, NGW = F.G * NWAVES;
    const float* MOD = (const float*)(F.ws + SM_MOD); const float* ng = F.in[I_NORMG];
    bf16* H = (bf16*)(F.ws + WS_H);
    for (int m = gw; m < NROW; m += NGW) {
        const float* src; int mr;
        if (m < NTOK) { src = F.in[I_X] + (size_t)m * D; mr = m / T; } else { src = F.in[I_CTX] + (size_t)(m - NTOK) * D; mr = 16; }
        const GAS f32x4* xr = (const GAS f32x4*)src + F.lane;
        f32x4 v[4]; float ss = 0.f;
#pragma unroll
        for (int j = 0; j < 4; ++j) { v[j] = __builtin_nontemporal_load(xr + 64 * j); ss += (v[j].x * v[j].x + v[j].y * v[j].y) + (v[j].z * v[j].z + v[j].w * v[j].w); }
        const float rstd = __builtin_amdgcn_rsqf(wave_sum(ss) * (1.f / D) + NORM_EPS);
        GAS v2u* o8 = (GAS v2u*)(H + (size_t)m * D) + F.lane;
#pragma unroll
        for (int j = 0; j < 4; ++j) { const int k = 4 * F.lane + 256 * j;
            const f32x4 g = *(const f32x4*)(ng + k), sh = *(const f32x4*)(MOD + mr * NMODC + k), sc = *(const f32x4*)(MOD + mr * NMODC + 1024 + k);
            const f32x4 y = v[j] * rstd * g * (sc + 1.f) + sh;
            v2u w; w.x = pk2(y.x, y.y); w.y = pk2(y.z, y.w); o8[64 * j] = w; }
    }
}

struct SchedIn {
    int G, c; const char* A; const char* Bt;
    __device__ __forceinline__ bool next(int i, pg8::Unit& u) const {
        const int L = i * G + c; if (L >= 3072) return false;
        if (G == 256) {
            const int q = i * 8 + (c & 7), k = c >> 3, kr = (k & ~7) | ((k + i) & 7);
            if (q < 64) { u.pm = 4 * (q & 31) + (kr >> 3); u.pn = (q >> 5) * 8 + (kr & 7); }
            else if (q < 92) { const int t = (q - 64) * 32 + k; u.pm = t / 7; u.pn = 16 + t % 7; }
            else { u.pm = 128 + 4 * (q - 92) + (kr >> 3); u.pn = kr & 7; }
            return true; }
        if (L < 2944) { const int g = L / 184, rem = L % 184; u.pn = rem >> 3; u.pm = g * 8 + (rem & 7); }
        else { const int l2 = L - 2944; u.pn = l2 >> 4; u.pm = 128 + (l2 & 15); }
        return true;
    }
    __device__ __forceinline__ const char* a_base(const pg8::Unit& u) const { return A + (size_t)u.pm * (256 * 1024 * 2); }
    __device__ __forceinline__ const char* b_base(const pg8::Unit& u) const { return Bt + (size_t)u.pn * (256 * 1024 * 2); }
};
__device__ __forceinline__ size_t lblk_off(int r, int j, int q) { return (size_t)((r & ~15) + 2 * j + (q >> 1)) * Z2P + 1024 + ((q & 1) * 16 + (r & 15)) * 8; }
struct EpiZ {
    unsigned char* ws;
    __device__ __forceinline__ void operator()(const pg8::f32x4 (&acc)[2][2][4][2], const pg8::Unit& u, int wr, int wc, int fr, int fq) const {
        bf16* base; int pitch, c0; const int pn = u.pn; float sc = 1.f;
        if (pn < 4) { base = (bf16*)(ws + WS_Z1); pitch = Z1P; c0 = pn * 256; if (pn < 2) sc = 0.08838834764831845f; }
        else if (pn < 9) { base = (bf16*)(ws + WS_Z2); pitch = Z2P; c0 = (pn - 4) * 256; }
        else if (pn < 11) { base = (bf16*)(ws + WS_Z3); pitch = Z3P; c0 = (pn - 9) * 256; }
        else if (pn < 13) { base = (bf16*)(ws + WS_Z4); pitch = Z4P; c0 = (pn - 11) * 256; }
        else if (pn < 15) { base = (bf16*)(ws + WS_Z5); pitch = Z5P; c0 = (pn - 13) * 256; }
        else { base = (bf16*)(ws + WS_Z6); pitch = Z6P; c0 = (pn - 15) * 256; }
        const int row0 = u.pm * 256 + wr * 64 + fr;
        if (pn < 2 || pn == 9 || pn == 10) {
            const float* CS = (const float*)(ws + SM_CS);
            const int d1 = 32 * (wc & 1) + 8 * fq, colb = c0 + (wc >> 1) * 128 + d1; const bool lat = u.pm < 128;
#pragma unroll
            for (int ai = 0; ai < 2; ++ai)
#pragma unroll
                for (int m = 0; m < 4; ++m) { const int row = row0 + ai * 128 + m * 16; const int t = row & (T - 1);
                    const int pos = d1 < 32 ? (t >> 6) : (t & 63); const float* cp = CS + (size_t)(pos * 32 + (d1 & 31)) * 2;
                    const pg8::f32x4 cs0 = *(const pg8::f32x4*)cp, cs1 = *(const pg8::f32x4*)(cp + 4), cs2 = *(const pg8::f32x4*)(cp + 8), cs3 = *(const pg8::f32x4*)(cp + 12);
                    const float cv[8] = {cs0[0], cs0[2], cs1[0], cs1[2], cs2[0], cs2[2], cs3[0], cs3[2]}, sv[8] = {cs0[1], cs0[3], cs1[1], cs1[3], cs2[1], cs2[3], cs3[1], cs3[3]};
                    float o1[8], o2[8];
#pragma unroll
                    for (int e = 0; e < 8; ++e) { const float x1 = acc[ai][0][m][e >> 2][e & 3] * sc, x2 = acc[ai][1][m][e >> 2][e & 3] * sc;
                        const float c = lat ? cv[e] : 1.f, s = lat ? sv[e] : 0.f; o1[e] = x1 * c - x2 * s; o2[e] = x1 * s + x2 * c; }
                    bf16* rowp = base + (size_t)row * pitch + colb;
                    v4u w1, w2; w1.x = pg8::cvt_pk_bf16(o1[0], o1[1]); w1.y = pg8::cvt_pk_bf16(o1[2], o1[3]); w1.z = pg8::cvt_pk_bf16(o1[4], o1[5]); w1.w = pg8::cvt_pk_bf16(o1[6], o1[7]);
                    w2.x = pg8::cvt_pk_bf16(o2[0], o2[1]); w2.y = pg8::cvt_pk_bf16(o2[2], o2[3]); w2.z = pg8::cvt_pk_bf16(o2[4], o2[5]); w2.w = pg8::cvt_pk_bf16(o2[6], o2[7]);
                    *(v4u*)rowp = w1; *(v4u*)(rowp + 64) = w2; }
            return;
        }
        if (pn >= 15) {
            bf16* tb = (bf16*)(ws + WS_Z6) + ((size_t)u.pm * 8 + (pn - 15)) * 65536 + (wr * 4 + wc) * 512 + (fq * 16 + fr) * 8;
#pragma unroll
            for (int ai = 0; ai < 2; ++ai)
#pragma unroll
                for (int m = 0; m < 4; ++m)
#pragma unroll
                    for (int bj = 0; bj < 2; ++bj) { const pg8::f32x4 v0 = acc[ai][bj][m][0], v1 = acc[ai][bj][m][1];
                        v4u w; w.x = pg8::cvt_pk_bf16(v0[0], v0[1]); w.y = pg8::cvt_pk_bf16(v0[2], v0[3]); w.z = pg8::cvt_pk_bf16(v1[0], v1[1]); w.w = pg8::cvt_pk_bf16(v1[2], v1[3]);
                        *(v4u*)(tb + (((ai * 4 + m) * 2 + bj) * 8) * 512) = w; }
            return;
        }
        if (pn == 8) {
#pragma unroll
            for (int ai = 0; ai < 2; ++ai)
#pragma unroll
                for (int m = 0; m < 4; ++m) { const int rg = u.pm * 256 + wr * 64 + ai * 128 + m * 16;
#pragma unroll
                    for (int bj = 0; bj < 2; ++bj) { bf16* dp = base + (size_t)(rg + 2 * (4 * bj + wc) + (fq >> 1)) * Z2P + 1024 + ((fq & 1) * 16 + fr) * 8;
                        const pg8::f32x4 v0 = acc[ai][bj][m][0], v1 = acc[ai][bj][m][1];
                        v4u w; w.x = pg8::cvt_pk_bf16(v0[0], v0[1]); w.y = pg8::cvt_pk_bf16(v0[2], v0[3]); w.z = pg8::cvt_pk_bf16(v1[0], v1[1]); w.w = pg8::cvt_pk_bf16(v1[2], v1[3]);
                        *(v4u*)dp = w; } }
            return;
        }
        if (pn == 6 || pn == 7) {
#pragma unroll
            for (int ai = 0; ai < 2; ++ai)
#pragma unroll
                for (int m = 0; m < 4; ++m) { const int rg = u.pm * 256 + wr * 64 + ai * 128 + m * 16;
#pragma unroll
                    for (int bj = 0; bj < 2; ++bj) { const int head = (pn - 6) * 4 + bj * 2 + (wc >> 1);
                        bf16* dp = base + (size_t)(rg + 2 * head + (wc & 1)) * Z2P + 512 + (fq >> 1) * 256 + ((fq & 1) * 16 + fr) * 8;
                        const pg8::f32x4 v0 = acc[ai][bj][m][0], v1 = acc[ai][bj][m][1];
                        v4u w; w.x = pg8::cvt_pk_bf16(v0[0], v0[1]); w.y = pg8::cvt_pk_bf16(v0[2], v0[3]); w.z = pg8::cvt_pk_bf16(v1[0], v1[1]); w.w = pg8::cvt_pk_bf16(v1[2], v1[3]);
                        *(v4u*)dp = w; } }
            return;
        }
        const int col0 = c0 + wc * 32 + 8 * fq;
#pragma unroll
        for (int ai = 0; ai < 2; ++ai)
#pragma unroll
            for (int m = 0; m < 4; ++m) { bf16* rowp = base + (size_t)(row0 + ai * 128 + m * 16) * pitch + col0;
#pragma unroll
                for (int bj = 0; bj < 2; ++bj) { const pg8::f32x4 v0 = acc[ai][bj][m][0] * sc, v1 = acc[ai][bj][m][1] * sc;
                    v4u w; w.x = pg8::cvt_pk_bf16(v0[0], v0[1]); w.y = pg8::cvt_pk_bf16(v0[2], v0[3]); w.z = pg8::cvt_pk_bf16(v1[0], v1[1]); w.w = pg8::cvt_pk_bf16(v1[2], v1[3]);
                    *(v4u*)(rowp + bj * 128) = w; } }
    }
};

__device__ __forceinline__ void p2_ctx_lora(Frame& F) {
    const bf16* H = (const bf16*)(F.ws + WS_H); const bf16* WinT = (const bf16*)(F.ws + WS_WINT); bf16* Z2 = (bf16*)(F.ws + WS_Z2);
    const int l = F.lane, i = l & 15, g = l >> 4;
    for (int su = F.bid; su < NCTX / 16; su += F.G) {
        const bf16* ap = H + (size_t)(NTOK + 16 * su + i) * 1024 + 8 * g; const bf16* bp = WinT + (size_t)(2048 + 16 * F.wave + i) * 1024 + 8 * g;
        pg8::f32x4 acc = (pg8::f32x4){0.f, 0.f, 0.f, 0.f};
#pragma unroll
        for (int hk = 0; hk < 2; ++hk) {
            pg8::bf16x8 av[16], bv[16];
#pragma unroll
            for (int ks = 0; ks < 16; ++ks) { av[ks] = *(const pg8::bf16x8*)(ap + 32 * (16 * hk + ks)); bv[ks] = *(const pg8::bf16x8*)(bp + 32 * (16 * hk + ks)); }
            __builtin_amdgcn_sched_barrier(0);
#pragma unroll
            for (int ks = 0; ks < 16; ++ks) acc = __builtin_amdgcn_mfma_f32_16x16x32_bf16(av[ks], bv[ks], acc, 0, 0, 0);
            __builtin_amdgcn_sched_barrier(0);
        }
#pragma unroll
        for (int r = 0; r < 4; ++r) { const int col = 16 * F.wave + i; Z2[lblk_off(NTOK + 16 * su + 4 * g + r, col >> 5, (col >> 3) & 3) + (col & 7)] = (bf16)f2bf(acc[r]); }
    }
}

__device__ __forceinline__ size_t vblk_off(int r, int hh, int c) { return (size_t)((r & ~15) + 2 * hh + (c >> 2)) * Z2P + 512 + ((c >> 1) & 1) * 256 + ((c & 1) * 16 + (r & 15)) * 8; }
__device__ __forceinline__ void p3_rope(Frame& F) {
    const int gw = F.bid * NWAVES + F.wave, NGW = F.G * NWAVES;
    const float* CS = (const float*)(F.ws + SM_CS);
    bf16* Z1 = (bf16*)(F.ws + WS_Z1); bf16* Z3 = (bf16*)(F.ws + WS_Z3);
    const int l = F.lane;
    for (int m = gw; m < NTOK; m += NGW) {
        const int t = m % T; const int pos = l < 32 ? t / GRIDW : t % GRIDW, f = l & 31;
        const float c = CS[(pos * 32 + f) * 2], s = CS[(pos * 32 + f) * 2 + 1];
#pragma unroll
        for (int h = 0; h < RH; ++h) {
            bf16* p = Z1 + (size_t)m * Z1P + h * RD + l; float x1 = bf2f(p[0]), x2 = bf2f(p[64]);
            p[0] = (bf16)f2bf(x1 * c - x2 * s); p[64] = (bf16)f2bf(x1 * s + x2 * c);
            bf16* q = Z3 + (size_t)m * Z3P + h * RD + l; x1 = bf2f(q[0]); x2 = bf2f(q[64]);
            q[0] = (bf16)f2bf(x1 * c - x2 * s); q[64] = (bf16)f2bf(x1 * s + x2 * c);
        }
    }
}

typedef short s16x4 __attribute__((ext_vector_type(4)));
__device__ __forceinline__ v4u scale8(const v4u x, float w) {
    v4u o; o.x = pg8::cvt_pk_bf16(bflo(x.x) * w, bfhi(x.x) * w); o.y = pg8::cvt_pk_bf16(bflo(x.y) * w, bfhi(x.y) * w);
    o.z = pg8::cvt_pk_bf16(bflo(x.z) * w, bfhi(x.z) * w); o.w = pg8::cvt_pk_bf16(bflo(x.w) * w, bfhi(x.w) * w); return o; }
__device__ __forceinline__ void p3_retstate(Frame& F) {
    using pg8::bf16x8; using pg8::f32x4;
    constexpr int KS = 288, VS = 160, KB = 64 * KS, VB = 64 * VS;
    const bf16* Z1 = (const bf16*)(F.ws + WS_Z1);
    bf16* RST = (bf16*)((unsigned char*)F.out + OUT_RST);
    const float* ld = F.in[I_RETLD];
    const int l = F.lane, i = l & 15, g = l >> 4, w = F.wave;
    const int kr0 = F.tid >> 4, kch = F.tid & 15, vr = F.tid >> 3, vch = F.tid & 7;
    const int tro = 4 * g + (i >> 2), tco = 8 * (i & 3);
    for (int it = F.bid; it < 256; it += F.G) {
        const int half = (it >> 3) & 1, idx = (it & 7) | ((it >> 4) << 3); const int dir = idx & 1, h = (idx >> 1) & 3, b = idx >> 3;
        const float lg = -__expf(ld[dir * RH + h]);
        const float g64 = __expf(64.f * lg);
        const float wk0 = __expf(lg * (float)(dir == 0 ? 63 - kr0 : kr0)), wk1 = __expf(lg * (float)(dir == 0 ? 31 - kr0 : kr0 + 32));
        f32x4 acc[4];
#pragma unroll
        for (int c = 0; c < 4; ++c) acc[c] = (f32x4){0.f, 0.f, 0.f, 0.f};
        v4u pkA[4][2], pvA[4], pkB[4][2], pvB[4];
#define RS_LOAD(PK, PV, cs) do { _Pragma("unroll") for (int q = 0; q < 4; ++q) { const int s_ = 4 * (cs) + q; \
            const int row0 = s_ < 4 ? NTOK + b * CL + 64 * (dir == 0 ? s_ : 3 - s_) : b * T + 64 * (dir == 0 ? s_ - 4 : 35 - s_); \
            const bf16* rb_ = Z1 + (size_t)row0 * Z1P + h * RD; \
            PK[q][0] = *(const v4u*)(rb_ + (size_t)kr0 * Z1P + kch * 8); PK[q][1] = *(const v4u*)(rb_ + (size_t)(kr0 + 32) * Z1P + kch * 8); \
            PV[q] = *(const v4u*)(rb_ + (size_t)vr * Z1P + 512 + half * 64 + vch * 8); } } while (0)
#define RS_STEP(PK, PV, cs) do { \
            _Pragma("unroll") for (int q = 0; q < 4; ++q) { \
                *(LAS v4u*)(F.lds + q * KB + kr0 * KS + kch * 16) = scale8(PK[q][0], wk0); *(LAS v4u*)(F.lds + q * KB + (kr0 + 32) * KS + kch * 16) = scale8(PK[q][1], wk1); \
                *(LAS v4u*)(F.lds + 4 * KB + q * VB + vr * VS + vch * 16) = PV[q]; } \
            __syncthreads(); \
            if ((cs) + 2 < 8) RS_LOAD(PK, PV, (cs) + 2); \
            _Pragma("unroll") for (int q = 0; q < 4; ++q) { \
                _Pragma("unroll") for (int c = 0; c < 4; ++c) acc[c] = acc[c] * g64; \
                _Pragma("unroll") for (int m = 0; m < 2; ++m) { \
                    const LAS unsigned char* kp = F.lds + q * KB + (tro + 32 * m) * KS + tco + w * 32; \
                    const s16x4 klo = __builtin_amdgcn_ds_read_tr16_b64_v4i16((LAS s16x4*)kp), khi = __builtin_amdgcn_ds_read_tr16_b64_v4i16((LAS s16x4*)(kp + 16 * KS)); \
                    const bf16x8 kf = __builtin_shufflevector(klo, khi, 0, 1, 2, 3, 4, 5, 6, 7); \
                    _Pragma("unroll") for (int c = 0; c < 4; ++c) { \
                        const LAS unsigned char* vp = F.lds + 4 * KB + q * VB + (tro + 32 * m) * VS + tco + c * 32; \
                        const s16x4 vlo = __builtin_amdgcn_ds_read_tr16_b64_v4i16((LAS s16x4*)vp), vhi = __builtin_amdgcn_ds_read_tr16_b64_v4i16((LAS s16x4*)(vp + 16 * VS)); \
                        const bf16x8 vf = __builtin_shufflevector(vlo, vhi, 0, 1, 2, 3, 4, 5, 6, 7); \
                        acc[c] = __builtin_amdgcn_mfma_f32_16x16x32_bf16(vf, kf, acc[c], 0, 0, 0); } } } \
              \
            { const int cidx = dir == 0 ? (cs) : 7 - (cs); \
              bf16* rp = RST + (((size_t)((b * RH + h) * 2 + dir) * 8 + cidx) * 128 + 16 * w + i) * 128 + 64 * half + 4 * g; \
              _Pragma("unroll") for (int c = 0; c < 4; ++c) { v2u ww; ww.x = pk2(acc[c][0], acc[c][1]); ww.y = pk2(acc[c][2], acc[c][3]); *(v2u*)(rp + 16 * c) = ww; } } \
            __syncthreads(); } while (0)
        RS_LOAD(pkA, pvA, 0); RS_LOAD(pkB, pvB, 1);
#pragma unroll 1
        for (int cs = 0; cs < 8; cs += 2) { RS_STEP(pkA, pvA, cs); RS_STEP(pkB, pvB, cs + 1); }
#undef RS_STEP
#undef RS_LOAD
    }
}

__device__ __forceinline__ void p4_retention(Frame& F) {
    using pg8::bf16x8; using pg8::f32x4;
    constexpr int KST = 272, VST = 288, KBY = 64 * KST, VBY = 64 * VST, RFO = 2 * KBY + 2 * VBY, RBY = 128 * VST;
    static_assert(RFO + 2 * RBY <= RING_BYTES, "retention LDS");
    const bf16* Z1 = (const bf16*)(F.ws + WS_Z1); const bf16* Z3 = (const bf16*)(F.ws + WS_Z3); const bf16* Z4 = (const bf16*)(F.ws + WS_Z4);
    const bf16* RST = (const bf16*)((const unsigned char*)F.out + OUT_RST);
    bf16* ARET = (bf16*)(F.ws + WS_ARET);
    const float* ld = F.in[I_RETLD]; const float* gn = F.in[I_RETGN];
    const int w = F.wave;
    for (int u = F.bid; u < 512; u += F.G) {
        int tv = F.tid; asm volatile("" : "+v"(tv));
        const int l = tv & 63, i = l & 15, g = l >> 4;
        const int kbase = i * KST + g * 16, vbase = (4 * g + (i >> 2)) * VST + 8 * (i & 3);
        const int sr0 = tv >> 4, sch = tv & 15;
        const int x = u & 7, qt = (u >> 3) & 7, yy = u >> 6; const int bh = x + 8 * yy; const int b = bh >> 2, h = bh & 3;
        const float lgf = -__expf(ld[h]), lgb = -__expf(ld[RH + h]);
        const int w0 = qt * 256 + 32 * w, wb = w0 >> 6;
        v4u pk0, pk1, pv0, pv1;
        { const bf16* rb = Z1 + (size_t)(b * T + 256 * qt) * Z1P + h * RD + sch * 8;
          pk0 = *(const v4u*)(rb + (size_t)sr0 * Z1P); pk1 = *(const v4u*)(rb + (size_t)(sr0 + 32) * Z1P);
          pv0 = *(const v4u*)(rb + (size_t)sr0 * Z1P + 512); pv1 = *(const v4u*)(rb + (size_t)(sr0 + 32) * Z1P + 512); }
        { const bf16* rf = RST + (((size_t)(bh * 2) * 8 + qt) * 128) * 128; const bf16* rbk = rf + (size_t)8 * 128 * 128;
          v4u a[4], c[4];
#pragma unroll
          for (int q = 0; q < 4; ++q) { a[q] = *(const v4u*)(rf + (size_t)q * 4096 + (sr0 * 128 + sch * 8)); c[q] = *(const v4u*)(rbk + (size_t)q * 4096 + (sr0 * 128 + sch * 8)); }
          LAS unsigned char* rl = F.lds + RFO + sr0 * VST + sch * 16;
#pragma unroll
          for (int q = 0; q < 4; ++q) { *(LAS v4u*)(rl + q * 32 * VST) = a[q]; *(LAS v4u*)(rl + RBY + q * 32 * VST) = c[q]; } }
        f32x4 OT[2][8];
#pragma unroll
        for (int rt = 0; rt < 2; ++rt)
#pragma unroll
            for (int c = 0; c < 8; ++c) OT[rt][c] = (f32x4){0.f, 0.f, 0.f, 0.f};
        *(LAS v4u*)(F.lds + sr0 * KST + sch * 16) = pk0; *(LAS v4u*)(F.lds + (sr0 + 32) * KST + sch * 16) = pk1;
        *(LAS v4u*)(F.lds + 2 * KBY + sr0 * VST + sch * 16) = pv0; *(LAS v4u*)(F.lds + 2 * KBY + (sr0 + 32) * VST + sch * 16) = pv1;
        __syncthreads();
        {
            bf16x8 Qp[2][4];
#pragma unroll
            for (int rt = 0; rt < 2; ++rt)
#pragma unroll
                for (int m = 0; m < 4; ++m) { const bf16* qp = Z3 + (size_t)(b * T + w0 + 16 * rt + i) * Z3P + h * RD + 32 * m + 4 * g;
                    const v2u a = *(const v2u*)qp, c = *(const v2u*)(qp + 16); pg8::u32x4 t4; t4.x = a.x; t4.y = a.y; t4.z = c.x; t4.w = c.y; Qp[rt][m] = __builtin_bit_cast(bf16x8, t4); }
#pragma unroll
            for (int dd = 0; dd < 2; ++dd) {
                const LAS unsigned char* Rb_ = F.lds + RFO + dd * RBY;
#pragma unroll
                for (int c = 0; c < 8; ++c)
#pragma unroll
                    for (int m = 0; m < 4; ++m) {
                        const s16x4 lo = __builtin_amdgcn_ds_read_tr16_b64_v4i16((LAS s16x4*)(Rb_ + vbase + (32 * m) * VST + c * 32));
                        const s16x4 hi = __builtin_amdgcn_ds_read_tr16_b64_v4i16((LAS s16x4*)(Rb_ + vbase + (32 * m + 16) * VST + c * 32));
                        const bf16x8 vf = __builtin_shufflevector(lo, hi, 0, 1, 2, 3, 4, 5, 6, 7);
                        OT[0][c] = __builtin_amdgcn_mfma_f32_16x16x32_bf16(vf, Qp[0][m], OT[0][c], 0, 0, 0);
                        OT[1][c] = __builtin_amdgcn_mfma_f32_16x16x32_bf16(vf, Qp[1][m], OT[1][c], 0, 0, 0);
                        if (m == 3) __builtin_amdgcn_sched_barrier(0); }
#pragma unroll
                for (int rt = 0; rt < 2; ++rt) { const int tl = 32 * w + 16 * rt + i;
                    const float ef = lgf * (float)(tl + 1), eb = lgb * (float)(256 - tl); const float sc = dd == 0 ? __expf(ef - eb) : __expf(eb);
#pragma unroll
                    for (int c = 0; c < 8; ++c) OT[rt][c] = OT[rt][c] * sc; }
            }
        }
        __builtin_amdgcn_sched_barrier(0);
        bf16x8 Qf[2][4];
#pragma unroll
        for (int rt = 0; rt < 2; ++rt)
#pragma unroll
            for (int s = 0; s < 4; ++s) Qf[rt][s] = *(const bf16x8*)(Z3 + (size_t)(b * T + w0 + 16 * rt + i) * Z3P + h * RD + 32 * s + 8 * g);
        const float cfg = __expf(lgf * (float)(63 - 4 * g)), cbg = __expf(lgb * (float)(4 * g));
        const float e1f = __expf(-lgf), e16f = __expf(-16.f * lgf), e1b = __expf(lgb), e16b = __expf(16.f * lgb);
#pragma unroll 1
        for (int kk = 0; kk < 4; ++kk) {
            const int kt = 4 * qt + kk, cb = kk & 1;
            if (kk + 1 < 4) { const int k2 = kt + 1;
                const bf16* rb = Z1 + (size_t)(b * T + 64 * k2) * Z1P + h * RD + sch * 8;
                pk0 = *(const v4u*)(rb + (size_t)sr0 * Z1P); pk1 = *(const v4u*)(rb + (size_t)(sr0 + 32) * Z1P);
                pv0 = *(const v4u*)(rb + (size_t)sr0 * Z1P + 512); pv1 = *(const v4u*)(rb + (size_t)(sr0 + 32) * Z1P + 512); }
            LAS unsigned char* Kb = F.lds + cb * KBY; LAS unsigned char* Vb = F.lds + 2 * KBY + cb * VBY;
            f32x4 S[2][4];
#pragma unroll
            for (int rt = 0; rt < 2; ++rt)
#pragma unroll
                for (int n = 0; n < 4; ++n) S[rt][n] = (f32x4){0.f, 0.f, 0.f, 0.f};
#pragma unroll
            for (int n = 0; n < 4; ++n)
#pragma unroll
                for (int s = 0; s < 4; ++s) { const bf16x8 kf = *(const LAS bf16x8*)(Kb + kbase + n * 16 * KST + s * 64);
                    S[0][n] = __builtin_amdgcn_mfma_f32_16x16x32_bf16(kf, Qf[0][s], S[0][n], 0, 0, 0);
                    S[1][n] = __builtin_amdgcn_mfma_f32_16x16x32_bf16(kf, Qf[1][s], S[1][n], 0, 0, 0);
                    if (s == 3) __builtin_amdgcn_sched_barrier(0); }
            if (kk + 1 < 4) { const int nb = cb ^ 1;
                *(LAS v4u*)(F.lds + nb * KBY + sr0 * KST + sch * 16) = pk0; *(LAS v4u*)(F.lds + nb * KBY + (sr0 + 32) * KST + sch * 16) = pk1;
                *(LAS v4u*)(F.lds + 2 * KBY + nb * VBY + sr0 * VST + sch * 16) = pv0; *(LAS v4u*)(F.lds + 2 * KBY + nb * VBY + (sr0 + 32) * VST + sch * 16) = pv1; }
            __builtin_amdgcn_sched_barrier(0);
            bf16x8 Pf[2][2];
            if (kt == wb) {
#pragma unroll
                for (int rt = 0; rt < 2; ++rt) { const int t = w0 + 16 * rt + i;
#pragma unroll
                    for (int n = 0; n < 4; ++n)
#pragma unroll
                        for (int r = 0; r < 4; ++r) { const int dist = t - (64 * kt + 16 * n + 4 * g + r);
                            const float wg = dist > 0 ? __expf(lgf * (float)dist) : (dist < 0 ? __expf(lgb * (float)(-dist)) : 2.f); S[rt][n][r] *= wg; } }
            } else {
#pragma unroll
                for (int rt = 0; rt < 2; ++rt) { const int t = w0 + 16 * rt + i; float ra, rb2;
                    if (kt < wb) { ra = __expf(lgf * (float)(t - 64 * kt - 63)); rb2 = 0.f; } else { ra = 0.f; rb2 = __expf(lgb * (float)(64 * kt - t)); }
                    float cnf = ra * cfg, cnb = rb2 * cbg;
#pragma unroll
                    for (int n = 0; n < 4; ++n) { float crf = cnf, crb = cnb;
#pragma unroll
                        for (int r = 0; r < 4; ++r) { S[rt][n][r] *= (crf + crb); crf *= e1f; crb *= e1b; }
                        cnf *= e16f; cnb *= e16b; } }
            }
#pragma unroll
            for (int rt = 0; rt < 2; ++rt)
#pragma unroll
                for (int m = 0; m < 2; ++m) { pg8::u32x4 pw; const f32x4 a = S[rt][2 * m], c2 = S[rt][2 * m + 1];
                    pw.x = pg8::cvt_pk_bf16(a[0], a[1]); pw.y = pg8::cvt_pk_bf16(a[2], a[3]); pw.z = pg8::cvt_pk_bf16(c2[0], c2[1]); pw.w = pg8::cvt_pk_bf16(c2[2], c2[3]);
                    Pf[rt][m] = __builtin_bit_cast(bf16x8, pw); }
#pragma unroll
            for (int c = 0; c < 8; ++c)
#pragma unroll
                for (int m = 0; m < 2; ++m) {
                    const s16x4 lo = __builtin_amdgcn_ds_read_tr16_b64_v4i16((LAS s16x4*)(Vb + vbase + (32 * m) * VST + c * 32));
                    const s16x4 hi = __builtin_amdgcn_ds_read_tr16_b64_v4i16((LAS s16x4*)(Vb + vbase + (32 * m + 16) * VST + c * 32));
                    const bf16x8 vf = __builtin_shufflevector(lo, hi, 0, 1, 2, 3, 4, 5, 6, 7);
                    OT[0][c] = __builtin_amdgcn_mfma_f32_16x16x32_bf16(vf, Pf[0][m], OT[0][c], 0, 0, 0);
                    OT[1][c] = __builtin_amdgcn_mfma_f32_16x16x32_bf16(vf, Pf[1][m], OT[1][c], 0, 0, 0);
                    if (m == 1) __builtin_amdgcn_sched_barrier(0); }
            __syncthreads();
        }
#pragma unroll
        for (int rt = 0; rt < 2; ++rt) {
            float s1 = 0.f;
#pragma unroll
            for (int c = 0; c < 8; ++c) s1 += (OT[rt][c][0] + OT[rt][c][1]) + (OT[rt][c][2] + OT[rt][c][3]);
            s1 = swap16_add(s1, s1); s1 = swap32_add(s1, s1);
            const float mean = s1 * (1.f / RD); float s2 = 0.f;
#pragma unroll
            for (int c = 0; c < 8; ++c) { OT[rt][c] = OT[rt][c] - mean; s2 += (OT[rt][c][0] * OT[rt][c][0] + OT[rt][c][1] * OT[rt][c][1]) + (OT[rt][c][2] * OT[rt][c][2] + OT[rt][c][3] * OT[rt][c][3]); }
            s2 = swap16_add(s2, s2); s2 = swap32_add(s2, s2);
            const float rstd = __builtin_amdgcn_rsqf(s2 * (1.f / RD) + 1e-5f);
            const size_t row = (size_t)(b * T + w0 + 16 * rt + i);
#pragma unroll
            for (int c = 0; c < 8; ++c) { const int col = h * RD + 16 * c + 4 * g;
                const v2u gz = *(const v2u*)(Z4 + row * Z4P + col); const f32x4 gg = *(const f32x4*)(gn + col);
                const f32x4 o = OT[rt][c] * rstd * gg;
                v2u ww; ww.x = pk2(siluf_(bflo(gz.x)) * o[0], siluf_(bfhi(gz.x)) * o[1]); ww.y = pk2(siluf_(bflo(gz.y)) * o[2], siluf_(bfhi(gz.y)) * o[3]);
                *(v2u*)(ARET + row * RW + col) = ww; }
        }
    }
}

__device__ __forceinline__ float shift3(float p, float c, float n, float mu0, float mu1) { return c + mu0 * (p - c) + mu1 * (n - c); }
__device__ __forceinline__ float shifted(const bf16* Z, int pitch, int row, int col, bool hasp, bool hasn, float mu0, float mu1) {
    const float c = bf2f(Z[(size_t)row * pitch + col]);
    const float p = hasp ? bf2f(Z[(size_t)(row - 1) * pitch + col]) : 0.f;
    const float n = hasn ? bf2f(Z[(size_t)(row + 1) * pitch + col]) : 0.f;
    return shift3(p, c, n, mu0, mu1);
}
__device__ __forceinline__ void row_bounds(int row, bool& hasp, bool& hasn) {
    if (row < NTOK) { const int t = row % T; hasp = t > 0; hasn = t < T - 1; } else { const int t = (row - NTOK) % CL; hasp = t > 0; hasn = t < CL - 1; }
}

__device__ __forceinline__ void unpack8(const v4u w, float (&f)[8]) { f[0] = bflo(w.x); f[1] = bfhi(w.x); f[2] = bflo(w.y); f[3] = bfhi(w.y); f[4] = bflo(w.z); f[5] = bfhi(w.z); f[6] = bflo(w.w); f[7] = bfhi(w.w); }
__device__ __forceinline__ void shifted8(const bf16* Z, int pitch, int row, int col0, bool hp, bool hn, const float* mu, int mi0, float (&o)[8]) {
    const v4u zero = (v4u){0u, 0u, 0u, 0u};
    const v4u c = *(const v4u*)(Z + (size_t)row * pitch + col0);
    const v4u px = *(const v4u*)(Z + (size_t)(row - (hp ? 1 : 0)) * pitch + col0), nx = *(const v4u*)(Z + (size_t)(row + (hn ? 1 : 0)) * pitch + col0);
    const v4u p = hp ? px : zero, n = hn ? nx : zero;
    float cf[8], pf[8], nf[8]; unpack8(c, cf); unpack8(p, pf); unpack8(n, nf);
    const f32x4 m0a = *(const f32x4*)(mu + mi0), m0b = *(const f32x4*)(mu + mi0 + 4), m1a = *(const f32x4*)(mu + 1792 + mi0), m1b = *(const f32x4*)(mu + 1792 + mi0 + 4);
#pragma unroll
    for (int e = 0; e < 8; ++e) { const float m0 = e < 4 ? m0a[e & 3] : m0b[e & 3], m1 = e < 4 ? m1a[e & 3] : m1b[e & 3]; o[e] = shift3(pf[e], cf[e], nf[e], m0, m1); }
}
__device__ __forceinline__ pg8::bf16x8 pack8(const float (&f)[8]) { pg8::u32x4 w; w.x = pg8::cvt_pk_bf16(f[0], f[1]); w.y = pg8::cvt_pk_bf16(f[2], f[3]); w.z = pg8::cvt_pk_bf16(f[4], f[5]); w.w = pg8::cvt_pk_bf16(f[6], f[7]); return __builtin_bit_cast(pg8::bf16x8, w); }
struct Sh3 { v4u c, p, n; };
__device__ __forceinline__ void shift_load(Sh3& r, const bf16* Z, int pitch, int row, int col0, bool hp, bool hn) {
    r.c = *(const v4u*)(Z + (size_t)row * pitch + col0);
    r.p = *(const v4u*)(Z + (size_t)(row - (hp ? 1 : 0)) * pitch + col0); r.n = *(const v4u*)(Z + (size_t)(row + (hn ? 1 : 0)) * pitch + col0);
}
__device__ __forceinline__ void shift_load_blk(Sh3& r, const bf16* Z2, int row, int j, int q, bool hp, bool hn) {
    r.c = *(const v4u*)(Z2 + lblk_off(row, j, q)); r.p = *(const v4u*)(Z2 + lblk_off(row - (hp ? 1 : 0), j, q)); r.n = *(const v4u*)(Z2 + lblk_off(row + (hn ? 1 : 0), j, q));
}
__device__ __forceinline__ void shift_apply(const Sh3& r, bool hp, bool hn, const float (&m0)[8], const float (&m1)[8], float (&o)[8]) {
    const v4u zero = (v4u){0u, 0u, 0u, 0u}; const v4u p = hp ? r.p : zero, n = hn ? r.n : zero;
    float cf[8], pf[8], nf[8]; unpack8(r.c, cf); unpack8(p, pf); unpack8(n, nf);
#pragma unroll
    for (int e = 0; e < 8; ++e) o[e] = shift3(pf[e], cf[e], nf[e], m0[e], m1[e]);
}
__device__ __forceinline__ void lds8(const LAS float* q, float (&m)[8]) { const f32x4 a = *(const LAS f32x4*)q, b = *(const LAS f32x4*)(q + 4); m[0] = a[0]; m[1] = a[1]; m[2] = a[2]; m[3] = a[3]; m[4] = b[0]; m[5] = b[1]; m[6] = b[2]; m[7] = b[3]; }
__device__ __forceinline__ void p5_prep(Frame& F) {
    using pg8::bf16x8;
    const int gw = F.bid * NWAVES + F.wave, NGW = F.G * NWAVES;
    const bf16* Z2 = (const bf16*)(F.ws + WS_Z2);
    bf16* WL = (bf16*)(F.ws + WS_WL); bf16* AA = (bf16*)F.out; float* KN = (float*)(F.ws + SM_KN);
    const float* mu = F.in[I_MU]; const float* w0 = F.in[I_W0]; const float* a0 = F.in[I_A0];
    const int l = F.lane, i = l & 15, g = l >> 4;
    const int d = F.bid & 1;
    __syncthreads();
    { const bf16* W2T = (const bf16*)(F.ws + SM_W2T) + (size_t)d * 512 * 64; const bf16* A2T = (const bf16*)(F.ws + SM_A2T) + (size_t)d * 512 * 64;
      v4u tw[8], ta[8];
#pragma unroll
      for (int q = 0; q < 8; ++q) { const int idx = F.tid + NTHR * q, r = idx >> 3, c = idx & 7; tw[q] = *(const v4u*)(W2T + (size_t)r * 64 + c * 8); ta[q] = *(const v4u*)(A2T + (size_t)r * 64 + c * 8); }
#pragma unroll
      for (int q = 0; q < 8; ++q) { const int idx = F.tid + NTHR * q, r = idx >> 3, c = idx & 7; const int slot = (r * 8 + (c ^ ((r >> 1) & 7))) * 16;
          *(LAS v4u*)(F.lds + slot) = tw[q]; *(LAS v4u*)(F.lds + 65536 + slot) = ta[q]; } }
    LAS float* CV5 = (LAS float*)(F.lds + 131072);
    { const int k = F.tid; CV5[k] = w0[d * 512 + k]; CV5[512 + k] = a0[d * 512 + k]; if (k < 128) { CV5[1024 + k] = mu[1024 + k]; CV5[1152 + k] = mu[1792 + 1024 + k]; } }
    {
        float m0[8], m1[8], kk8[8];
#pragma unroll
        for (int e = 0; e < 8; ++e) { m0[e] = mu[8 * l + e]; m1[e] = mu[1792 + 8 * l + e]; kk8[e] = F.in[I_KK][8 * l + e]; }
        for (int row0 = gw; row0 < NROW; row0 += 6 * NGW) {
            Sh3 sh[6]; bool hp[6], hn[6];
#pragma unroll
            for (int u = 0; u < 6; ++u) { const int rw = row0 + u * NGW; const int r = rw < NROW ? rw : row0; row_bounds(r, hp[u], hn[u]); shift_load(sh[u], Z2, Z2P, r, 8 * l, hp[u], hn[u]); }
            __builtin_amdgcn_sched_barrier(0);
#pragma unroll
            for (int u = 0; u < 6; ++u) { const int rw = row0 + u * NGW; float ks[8]; shift_apply(sh[u], hp[u], hn[u], m0, m1, ks);
                float ss = 0.f;
#pragma unroll
                for (int e = 0; e < 8; ++e) { const float v = ks[e] * kk8[e]; ss += v * v; }
                ss = red8(ss);
                if ((l & 7) == 0 && rw < NROW) KN[rw * 8 + (l >> 3)] = __builtin_amdgcn_rsqf(ss + 1e-12f); }
        }
    }
    __syncthreads();
    const int wv = (F.bid >> 1) * NWAVES + F.wave, NWV = (F.G >> 1) * NWAVES;
    for (int task = wv; task < (NROW / 32) * 4; task += NWV) {
        const int tok0 = (task % (NROW / 32)) * 32, ntq = task / (NROW / 32);
        bf16x8 Bw[2][2], Ba[2][2];
        { Sh3 sw[2][2], sa[2][2]; bool hp[2], hn[2];
#pragma unroll
          for (int tl = 0; tl < 2; ++tl) { const int row = tok0 + 16 * tl + i; row_bounds(row, hp[tl], hn[tl]);
#pragma unroll
              for (int ks = 0; ks < 2; ++ks) { shift_load_blk(sw[tl][ks], Z2, row, ks, g, hp[tl], hn[tl]); shift_load_blk(sa[tl][ks], Z2, row, 2 + ks, g, hp[tl], hn[tl]); } }
          __builtin_amdgcn_sched_barrier(0);
#pragma unroll
          for (int ks = 0; ks < 2; ++ks) { float m0w[8], m1w[8], m0a[8], m1a[8];
              lds8(CV5 + 1024 + 32 * ks + 8 * g, m0w); lds8(CV5 + 1152 + 32 * ks + 8 * g, m1w); lds8(CV5 + 1024 + 64 + 32 * ks + 8 * g, m0a); lds8(CV5 + 1152 + 64 + 32 * ks + 8 * g, m1a);
#pragma unroll
              for (int tl = 0; tl < 2; ++tl) { float v[8];
                  shift_apply(sw[tl][ks], hp[tl], hn[tl], m0w, m1w, v);
#pragma unroll
                  for (int e = 0; e < 8; ++e) { const float ex = __expf(2.f * fminf(fmaxf(v[e], -15.f), 15.f)); v[e] = (ex - 1.f) * __builtin_amdgcn_rcpf(ex + 1.f); }
                  Bw[tl][ks] = pack8(v);
                  shift_apply(sa[tl][ks], hp[tl], hn[tl], m0a, m1a, v);
                  Ba[tl][ks] = pack8(v); } } }
        const int sw0 = (g ^ ((i >> 1) & 7)) * 16, sw1 = ((4 + g) ^ ((i >> 1) & 7)) * 16;
#pragma unroll 2
        for (int nq = 0; nq < 8; ++nq) { const int nt = 8 * ntq + nq;
            const LAS unsigned char* rp = F.lds + (16 * nt + i) * 128;
            const bf16x8 wf0 = *(const LAS bf16x8*)(rp + sw0), wf1 = *(const LAS bf16x8*)(rp + sw1), af0 = *(const LAS bf16x8*)(rp + 65536 + sw0), af1 = *(const LAS bf16x8*)(rp + 65536 + sw1);
            const int ch0 = 16 * nt + 4 * g;
            const f32x4 w0v = *(const LAS f32x4*)(CV5 + ch0), a0v = *(const LAS f32x4*)(CV5 + 512 + ch0);
#pragma unroll
            for (int tl = 0; tl < 2; ++tl) {
                f32x4 aw = (f32x4){0.f, 0.f, 0.f, 0.f}, aa = (f32x4){0.f, 0.f, 0.f, 0.f};
                aw = __builtin_amdgcn_mfma_f32_16x16x32_bf16(wf0, Bw[tl][0], aw, 0, 0, 0); aw = __builtin_amdgcn_mfma_f32_16x16x32_bf16(wf1, Bw[tl][1], aw, 0, 0, 0);
                aa = __builtin_amdgcn_mfma_f32_16x16x32_bf16(af0, Ba[tl][0], aa, 0, 0, 0); aa = __builtin_amdgcn_mfma_f32_16x16x32_bf16(af1, Ba[tl][1], aa, 0, 0, 0);
                aw = aw + w0v; aa = aa + a0v;
                const size_t o = (size_t)d * NROW * 512 + ((size_t)((tok0 + 16 * tl) >> 4) * 8 + (nt >> 2)) * 1024 + (nt & 3) * 256 + ((g >> 1) * 16 + i) * 8 + (g & 1) * 4;
                v2u ww; ww.x = pk2(-0.6065306597f * sigmoidf_(aw[0]), -0.6065306597f * sigmoidf_(aw[1])); ww.y = pk2(-0.6065306597f * sigmoidf_(aw[2]), -0.6065306597f * sigmoidf_(aw[3]));
                *(v2u*)(WL + o) = ww;
                v2u wa; wa.x = pk2(sigmoidf_(aa[0]), sigmoidf_(aa[1])); wa.y = pk2(sigmoidf_(aa[2]), sigmoidf_(aa[3]));
                *(v2u*)(AA + o) = wa; }
        }
    }
    __syncthreads();
}

__device__ __forceinline__ void scan_rowinfo(int b, int d, int s, int& row, bool& hp, bool& hn, bool& lat) {
    if (s < CL) { const int pos = d == 0 ? s : CL - 1 - s; row = NTOK + b * CL + pos; hp = pos > 0; hn = pos < CL - 1; lat = false; }
    else { const int s2 = s - CL; const int pos = d == 0 ? s2 : T - 1 - s2; row = b * T + pos; hp = pos > 0; hn = pos < T - 1; lat = true; }
}
constexpr int SC_TS = 32;
constexpr int CS_RS64 = 144, CS_RS32 = 80;
constexpr int CS_KKP = 0, CS_KAP = 4608, CS_KDP = 9216, CS_RP = 13824, CS_KAT = 18432, CS_KDT = 23552, CS_VM = 28672, CS_WC = 33792, CS_SET = 34048;
constexpr int CS_S0A = 2 * CS_SET, CS_S0B = CS_S0A + 9216, CS_CT = CS_S0B + 9216, CS_DMT = CS_CT + 4608, CS_A2T = CS_DMT + 2560, CS_B2T = CS_A2T + 2560, CS_RHS = CS_B2T + 2560, CS_SA = CS_RHS + 8704;
constexpr int CS_NSW = 8, CS_SPW = 4;
constexpr int CS_PS = CS_SA + 5120;
constexpr int CS_RAW = CS_PS + 4096;
static_assert(CS_RAW + CS_NSW * 4096 <= RING_BYTES, "chunked scan LDS");
#define CS_BAR() do { asm volatile("s_waitcnt lgkmcnt(0)" ::: "memory"); __builtin_amdgcn_s_barrier(); asm volatile("" ::: "memory"); } while (0)
#define CS_FRAG(base, RS, rbase, k0) (*(const LAS pg8::bf16x8*)((base) + ((rbase) * (RS) + (k0) * 2) + ((RS) == CS_RS64 ? lo64 : lo32)))
struct ScanRaw { float kr[6], vr[6], rr[6], av[4], wl4[4]; };
#define CS_GLDS(gp, lp) __builtin_amdgcn_global_load_lds((const unsigned*)(gp), (LAS unsigned*)(lp), 16, 0, 0)
template <int DIR> __device__ __forceinline__ void cscan_dma(Frame& F, int b, int h, int cidx, float (&knv)[4]) {
    const bf16* Z2 = (const bf16*)(F.ws + WS_Z2); const bf16* Z5 = (const bf16*)(F.ws + WS_Z5);
    const bf16* WL = (const bf16*)(F.ws + WS_WL); const bf16* AA = (const bf16*)F.out; const float* KN = (const float*)(F.ws + SM_KN);
    const int l = F.lane, sw = F.wave, rr = l >> 3, cc = l & 7;
    const bool lat = cidx >= CL / SC_TS;
    const int len = lat ? T : CL, base = lat ? b * T : NTOK + b * CL;
    const int c0 = lat ? cidx * SC_TS - CL : cidx * SC_TS;
    const int s0 = c0 + sw * CS_SPW;
    const int lo = DIR == 0 ? s0 - 1 : len - 1 - s0 - CS_SPW;
    LAS unsigned char* slot = F.lds + CS_RAW + sw * 4096;
    const int p0 = min(max(lo + rr, 0), len - 1);
    const bf16* k0 = Z2 + (size_t)(base + p0) * Z2P + h * 64 + cc * 8;
    const bf16* r0 = Z5 + (size_t)(lat ? base + p0 : 0) * Z5P + h * 64 + cc * 8;
    const int ar_ = base + lo + 1 + (rr & 3); const size_t arow = (size_t)DIR * NROW * 512 + ((size_t)(ar_ >> 4) * 8 + h) * 1024 + (cc >> 1) * 256 + ((cc & 1) * 16 + (ar_ & 15)) * 8;
    CS_GLDS(k0, slot); CS_GLDS(Z2 + vblk_off(base + p0, h, cc), slot + 1024); CS_GLDS(r0, slot + 2048); CS_GLDS((rr < 4 ? AA : WL) + arow, slot + 3072);
    unsigned vzero; asm("v_mov_b32 %0, 0" : "=v"(vzero));
    const float* kp = KN + (size_t)(base + lo) * 8 + h;
#pragma unroll
    for (int jj = 0; jj < CS_SPW; ++jj) { const int q = DIR == 0 ? jj + 1 : CS_SPW - jj; knv[jj] = kp[(unsigned)(q * 8) + vzero]; }
}
template <int DIR> __device__ __forceinline__ void cscan_rawread(Frame& F, int cidx, ScanRaw& R) {
    const int l = F.lane, sw = F.wave;
    const bool lat = cidx >= CL / SC_TS; const int len = lat ? T : CL;
    const int c0 = lat ? cidx * SC_TS - CL : cidx * SC_TS; const int s0 = c0 + sw * CS_SPW;
    const int lo = DIR == 0 ? s0 - 1 : len - 1 - s0 - CS_SPW;
    const bool ok0 = lo >= 0, ok5 = lo + 5 < len;
    const LAS unsigned char* slot = F.lds + CS_RAW + sw * 4096 + l * 2;
#pragma unroll
    for (int q = 0; q < 6; ++q) { const bool ok = q == 0 ? ok0 : (q == 5 ? ok5 : true);
        const float kx = bf2f(*(const LAS bf16*)(slot + q * 128)), vx = bf2f(*(const LAS bf16*)(slot + 1024 + q * 128)), rx = bf2f(*(const LAS bf16*)(slot + 2048 + q * 128));
        R.kr[q] = ok ? kx : 0.f; R.vr[q] = ok ? vx : 0.f; R.rr[q] = (ok && lat) ? rx : 0.f; }
#pragma unroll
    for (int jj = 0; jj < CS_SPW; ++jj) { const int idx = DIR == 0 ? jj : CS_SPW - 1 - jj;
        R.av[jj] = bf2f(*(const LAS bf16*)(slot + 3072 + idx * 128)); R.wl4[jj] = bf2f(*(const LAS bf16*)(slot + 3584 + idx * 128)); }
}
__device__ __forceinline__ void cscan_psum(Frame& F, int cidx) {
    const LAS unsigned char* slot = F.lds + CS_RAW + F.wave * 4096 + 3584 + F.lane * 2;
    float s = 0.f;
#pragma unroll
    for (int jj = 0; jj < CS_SPW; ++jj) s += bf2f(*(const LAS bf16*)(slot + jj * 128));
    *(LAS float*)(F.lds + CS_PS + (((cidx & 1) * CS_NSW + F.wave) * 64 + F.lane) * 4) = s;
}
struct ScanConst { float mk0, mk1, mv0, mv1, mr0, mr1, kkc, kac, rkc; };
template <int DIR> __device__ __forceinline__ void cscan_stage(Frame& F, int b, int h, int cidx, const ScanRaw& R, const float (&knv)[4], const ScanConst& K, LAS unsigned char* set, float& bsval, unsigned& bsidx) {
    const int l = F.lane, sw = F.wave;
    const bool lat = cidx >= CL / SC_TS;
    const int len = lat ? T : CL, base = lat ? b * T : NTOK + b * CL;
    const int c0 = lat ? cidx * SC_TS - CL : cidx * SC_TS;
    const int s0 = c0 + sw * CS_SPW;
    const int lo = DIR == 0 ? s0 - 1 : len - 1 - s0 - CS_SPW;
    const float mk0 = K.mk0, mk1 = K.mk1, mv0 = K.mv0, mv1 = K.mv1, mr0 = K.mr0, mr1 = K.mr1, kkc = K.kkc, kac = K.kac, rkc = K.rkc;
    float cw = 0.f;
#pragma unroll
    for (int q2 = 0; q2 < CS_NSW - 1; ++q2) { const float ps = *(const LAS float*)(F.lds + CS_PS + (((cidx & 1) * CS_NSW + q2) * 64 + l) * 4); cw += (q2 < sw) ? ps : 0.f; }
    float epv = __expf(cw);
    float bsv[CS_SPW]; unsigned tka[CS_SPW], tkd[CS_SPW], tv[CS_SPW];
#pragma unroll
    for (int jj = 0; jj < CS_SPW; ++jj) { const int q = DIR == 0 ? jj + 1 : CS_SPW - jj; const int t = sw * CS_SPW + jj;
        const float ks = shift3(R.kr[q - 1], R.kr[q], R.kr[q + 1], mk0, mk1), vs = shift3(R.vr[q - 1], R.vr[q], R.vr[q + 1], mv0, mv1), rs = shift3(R.rr[q - 1], R.rr[q], R.rr[q + 1], mr0, mr1);
        const float a = R.av[jj];
        const float kkv = ks * kkc * knv[jj], kdir = ks * (1.f + (a - 1.f) * kac), kka = kkv * a;
        bsv[jj] = rs * kdir * rkc;
        const float ekp = epv; cw += R.wl4[jj]; const float ep = __expf(cw), emn = __builtin_amdgcn_rcpf(ep); epv = ep;
        const unsigned pa = pg8::cvt_pk_bf16(kkv * ekp, kka * emn), pb = pg8::cvt_pk_bf16(kdir * emn, rs * ep), pc = pg8::cvt_pk_bf16(vs, 0.f);
        *(LAS bf16*)(set + CS_KKP + t * CS_RS64 + l * 2) = (bf16)(pa & 0xffffu);
        *(LAS bf16*)(set + CS_KAP + t * CS_RS64 + l * 2) = (bf16)(pa >> 16);
        *(LAS bf16*)(set + CS_KDP + t * CS_RS64 + l * 2) = (bf16)(pb & 0xffffu);
        *(LAS bf16*)(set + CS_RP + t * CS_RS64 + l * 2) = (bf16)(pb >> 16);
        tka[jj] = pa >> 16; tkd[jj] = pb & 0xffffu; tv[jj] = pc & 0xffffu;
        __builtin_amdgcn_sched_barrier(0); }
    { v2u w; w.x = tka[0] | (tka[1] << 16); w.y = tka[2] | (tka[3] << 16); *(LAS v2u*)(set + CS_KAT + l * CS_RS32 + sw * 8) = w;
      w.x = tkd[0] | (tkd[1] << 16); w.y = tkd[2] | (tkd[3] << 16); *(LAS v2u*)(set + CS_KDT + l * CS_RS32 + sw * 8) = w;
      w.x = tv[0] | (tv[1] << 16); w.y = tv[2] | (tv[3] << 16); *(LAS v2u*)(set + CS_VM + l * CS_RS32 + sw * 8) = w; }
    if (sw == CS_NSW - 1) *(LAS float*)(set + CS_WC + l * 4) = __expf(cw);
    if (lat) {
        float bv = swap16_add(swap32_add(bsv[0], bsv[2]), swap32_add(bsv[1], bsv[3]));
        bv += dpp_f<0xB1>(bv); bv += dpp_f<0x4E>(bv); bv += dpp_f<0x141>(bv); bv += dpp_f<0x140>(bv);
        const int jl = l >> 4; const int q = DIR == 0 ? jl + 1 : CS_SPW - jl;
        bsval = bv; bsidx = (unsigned)((DIR * NTOK + base + lo + q) * 8 + h); }
}
__device__ __forceinline__ void cs_phase1(LAS unsigned char* L, const LAS unsigned char* set, int w, int il, int g) {
    using pg8::bf16x8;
    const int lo64 = il * CS_RS64 + g * 16, lo32 = il * CS_RS32 + g * 16;
    const int X = w >> 1, mt = w & 1;
    const LAS unsigned char* Lf = set + (X < 2 ? CS_KKP : CS_RP); const LAS unsigned char* Rt = set + ((X & 1) ? CS_KDP : CS_KAP);
    const bf16x8 a0 = CS_FRAG(Lf, CS_RS64, 16 * mt, 0), a1 = CS_FRAG(Lf, CS_RS64, 16 * mt, 32);
#pragma unroll
    for (int nt = 0; nt < 2; ++nt) {
        f32x4 acc = (f32x4){0.f, 0.f, 0.f, 0.f};
        acc = __builtin_amdgcn_mfma_f32_16x16x32_bf16(a0, CS_FRAG(Rt, CS_RS64, 16 * nt, 0), acc, 0, 0, 0);
        acc = __builtin_amdgcn_mfma_f32_16x16x32_bf16(a1, CS_FRAG(Rt, CS_RS64, 16 * nt, 32), acc, 0, 0, 0);
        const int tau = 16 * nt + il;
        const int tsh = X < 2 ? 0 : 1;
        float v[4];
#pragma unroll
        for (int r = 0; r < 4; ++r) v[r] = (tau < 16 * mt + 4 * g + r + tsh) ? acc[r] : 0.f;
        if (X == 0) {
#pragma unroll
            for (int r = 0; r < 4; ++r) *(LAS float*)(L + CS_CT + (16 * mt + 4 * g + r) * 144 + ((tau & 3) * 8 + (tau >> 2)) * 4) = v[r];
        } else { LAS unsigned char* ob = L + (X == 1 ? CS_DMT : (X == 2 ? CS_A2T : CS_B2T)) + (16 * mt + 4 * g) * CS_RS32 + tau * 2;
            const unsigned p01 = pg8::cvt_pk_bf16(v[0], v[1]), p23 = pg8::cvt_pk_bf16(v[2], v[3]);
            *(LAS bf16*)(ob) = (bf16)(p01 & 0xffffu); *(LAS bf16*)(ob + CS_RS32) = (bf16)(p01 >> 16); *(LAS bf16*)(ob + 2 * CS_RS32) = (bf16)(p23 & 0xffffu); *(LAS bf16*)(ob + 3 * CS_RS32) = (bf16)(p23 >> 16); }
    }
}
__device__ __forceinline__ void cs_phase2(LAS unsigned char* L, const LAS unsigned char* set, const LAS unsigned char* S0, int w, int il, int g) {
    const int lo64 = il * CS_RS64 + g * 16, lo32 = il * CS_RS32 + g * 16;
    const int mt = w >> 1, nt = w & 1;
    f32x4 acc = (f32x4){0.f, 0.f, 0.f, 0.f};
    acc = __builtin_amdgcn_mfma_f32_16x16x32_bf16(CS_FRAG(S0, CS_RS64, 16 * mt, 0), CS_FRAG(set + CS_KKP, CS_RS64, 16 * nt, 0), acc, 0, 0, 0);
    acc = __builtin_amdgcn_mfma_f32_16x16x32_bf16(CS_FRAG(S0, CS_RS64, 16 * mt, 32), CS_FRAG(set + CS_KKP, CS_RS64, 16 * nt, 32), acc, 0, 0, 0);
    acc = __builtin_amdgcn_mfma_f32_16x16x32_bf16(CS_FRAG(set + CS_VM, CS_RS32, 16 * mt, 0), CS_FRAG(L + CS_DMT, CS_RS32, 16 * nt, 0), acc, 0, 0, 0);
    *(LAS f32x4*)(L + CS_RHS + (16 * nt + il) * 272 + (16 * mt + 4 * g) * 4) = -acc;
}
template <int DIR> __device__ __forceinline__ void cs_phase4(LAS unsigned char* L, const LAS unsigned char* set, const LAS unsigned char* S0, LAS unsigned char* S0n, f32x4 (&Sacc)[2],
                                                              int w, int il, int g, int c, int b, int h, v2u& odv, unsigned& odo) {
    using pg8::bf16x8;
    const int lo64 = il * CS_RS64 + g * 16, lo32 = il * CS_RS32 + g * 16;
    constexpr int CCH = CL / SC_TS;
    const int mt = w >> 1, nt = w & 1;
    f32x4 acc = (f32x4){0.f, 0.f, 0.f, 0.f};
    acc = __builtin_amdgcn_mfma_f32_16x16x32_bf16(CS_FRAG(S0, CS_RS64, 16 * mt, 0), CS_FRAG(set + CS_RP, CS_RS64, 16 * nt, 0), acc, 0, 0, 0);
    acc = __builtin_amdgcn_mfma_f32_16x16x32_bf16(CS_FRAG(S0, CS_RS64, 16 * mt, 32), CS_FRAG(set + CS_RP, CS_RS64, 16 * nt, 32), acc, 0, 0, 0);
    const bf16x8 saf = CS_FRAG(L + CS_SA, CS_RS32, 16 * mt, 0), vmf = CS_FRAG(set + CS_VM, CS_RS32, 16 * mt, 0);
    acc = __builtin_amdgcn_mfma_f32_16x16x32_bf16(saf, CS_FRAG(L + CS_A2T, CS_RS32, 16 * nt, 0), acc, 0, 0, 0);
    acc = __builtin_amdgcn_mfma_f32_16x16x32_bf16(vmf, CS_FRAG(L + CS_B2T, CS_RS32, 16 * nt, 0), acc, 0, 0, 0);
    if (c >= CCH) { const int sq = (c - CCH) * SC_TS + 16 * nt + il; const int pos = DIR == 0 ? sq : T - 1 - sq;
        odv.x = pk2(acc[0], acc[1]); odv.y = pk2(acc[2], acc[3]); odo = (unsigned)(((pos >> 4) * 8 + h) * 1024 + mt * 256 + ((g >> 1) * 16 + (pos & 15)) * 8 + (g & 1) * 4); }
#pragma unroll
    for (int q = 0; q < 2; ++q) { const int nj = 2 * (w & 1) + q;
        Sacc[q] = __builtin_amdgcn_mfma_f32_16x16x32_bf16(saf, CS_FRAG(set + CS_KAT, CS_RS32, 16 * nj, 0), Sacc[q], 0, 0, 0);
        Sacc[q] = __builtin_amdgcn_mfma_f32_16x16x32_bf16(vmf, CS_FRAG(set + CS_KDT, CS_RS32, 16 * nj, 0), Sacc[q], 0, 0, 0);
        const float wc = *(const LAS float*)(set + CS_WC + (16 * nj + il) * 4);
        Sacc[q] = Sacc[q] * wc;
        { const unsigned p01 = pk2(Sacc[q][0], Sacc[q][1]), p23 = pk2(Sacc[q][2], Sacc[q][3]); LAS unsigned char* sp = S0n + (16 * mt + 4 * g) * CS_RS64 + (16 * nj + il) * 2;
          *(LAS bf16*)(sp) = (bf16)(p01 & 0xffffu); *(LAS bf16*)(sp + CS_RS64) = (bf16)(p01 >> 16); *(LAS bf16*)(sp + 2 * CS_RS64) = (bf16)(p23 & 0xffffu); *(LAS bf16*)(sp + 3 * CS_RS64) = (bf16)(p23 >> 16); } }
}
__device__ __forceinline__ void cs_solve(LAS unsigned char* L, int w, int l) {
    const int ri = l >> 2, kq = l & 3;
    const LAS unsigned char* ctb = L + CS_CT + kq * 32;
    const LAS unsigned char* rhb = L + CS_RHS + (16 * w + ri) * 4;
    float sv[8];
#pragma unroll
    for (int q = 0; q < 8; ++q) sv[q] = 0.f;
    float snew = 0.f;
    f32x4 cA[32], cB[32]; float rh[32];
#define CS_SLOAD(j) do { _Pragma("unroll") for (int t_ = 4 * (j); t_ < 4 * (j) + 4; ++t_) { cA[t_] = *(const LAS f32x4*)(ctb + t_ * 144); if (t_ >= 17) cB[t_] = *(const LAS f32x4*)(ctb + t_ * 144 + 16); \
        rh[t_] = *(const LAS float*)(rhb + t_ * 272); } } while (0)
    CS_SLOAD(0);
#pragma unroll
    for (int j = 0; j < 8; ++j) {
        if (j == 0) CS_SLOAD(1); else if (j == 1) CS_SLOAD(2); else if (j == 2) CS_SLOAD(3); else if (j == 3) CS_SLOAD(4); else if (j == 4) CS_SLOAD(5); else if (j == 5) CS_SLOAD(6); else if (j == 6) CS_SLOAD(7);
        __builtin_amdgcn_sched_barrier(0);
#pragma unroll
        for (int t = 4 * j; t < 4 * j + 4; ++t) {
            float cq[8] = {cA[t][0], cA[t][1], cA[t][2], cA[t][3], 0.f, 0.f, 0.f, 0.f};
            if (t >= 17) { cq[4] = cB[t][0]; cq[5] = cB[t][1]; cq[6] = cB[t][2]; cq[7] = cB[t][3]; }
            float older = 0.f;
#pragma unroll
            for (int q = 0; q < 8; ++q) if (t >= 2 && q <= ((t - 2) >> 2)) older = __builtin_fmaf(sv[q], cq[q], older);
            float acc = older;
            if (t >= 1) { const float cn = (kq == ((t - 1) & 3)) ? cq[(t - 1) >> 2] : 0.f; acc = __builtin_fmaf(snew, cn, older);
                sv[(t - 1) >> 2] = (kq == ((t - 1) & 3)) ? snew : sv[(t - 1) >> 2]; }
            acc += dpp_f<0xB1>(acc); acc += dpp_f<0x4E>(acc);
            snew = rh[t] - acc;
        }
        __builtin_amdgcn_sched_barrier(0);
    }
#undef CS_SLOAD
    sv[7] = (kq == 3) ? snew : sv[7];
#pragma unroll
    for (int q = 0; q < 8; ++q) *(LAS bf16*)(L + CS_SA + (16 * w + ri) * CS_RS32 + (4 * q + kq) * 2) = (bf16)f2bf(sv[q]);
}
template <int DIR, bool SOLVER> __device__ __forceinline__ void cscan_loop(Frame& F, int b, int h) {
    using pg8::bf16x8;
    const int l = F.lane, w = F.wave, il = l & 15, g = l >> 4;
    LAS unsigned char* L = F.lds;
    constexpr int NCH = (CL + T) / SC_TS;
    bf16* OD = (bf16*)(F.ws + (DIR == 0 ? WS_OF : WS_OB));
    f32x4 Sacc[2] = {(f32x4){0.f, 0.f, 0.f, 0.f}, (f32x4){0.f, 0.f, 0.f, 0.f}};
    ScanRaw raw; float knC[4], knN[4];
    ScanConst KC; { const float* mu = F.in[I_MU]; const int ch = h * 64 + l; KC.mk0 = mu[ch]; KC.mk1 = mu[1792 + ch]; KC.mv0 = mu[512 + ch]; KC.mv1 = mu[1792 + 512 + ch]; KC.mr0 = mu[1152 + ch]; KC.mr1 = mu[1792 + 1152 + ch];
      KC.kkc = F.in[I_KK][ch]; KC.kac = F.in[I_KA][ch]; KC.rkc = F.in[I_RK][ch]; }
    cscan_dma<DIR>(F, b, h, 0, knC);
    asm volatile("s_waitcnt vmcnt(0)" ::: "memory");
    cscan_psum(F, 0);
    CS_BAR();
    cscan_rawread<DIR>(F, 0, raw);
    asm volatile("s_waitcnt lgkmcnt(0)" ::: "memory");
    cscan_dma<DIR>(F, b, h, 1, knN);
    float* BS = (float*)(F.ws + SM_BS); bf16* ODb = OD + (size_t)b * T * 512;
    v2u odv = (v2u){0u, 0u}; unsigned odo = 0u; bool odp = false; float bsval = 0.f; unsigned bsidx = 0u; bool bsp = false;
    cscan_stage<DIR>(F, b, h, 0, raw, knC, KC, L, bsval, bsidx);
    CS_BAR();
    for (int c = 0; c < NCH; ++c) {
        LAS unsigned char* set = L + (c & 1) * CS_SET; LAS unsigned char* S0 = L + ((c & 1) ? CS_S0B : CS_S0A); LAS unsigned char* S0n = L + ((c & 1) ? CS_S0A : CS_S0B);
        cs_phase1(L, set, w, il, g);
        CS_BAR();
        cs_phase2(L, set, S0, w, il, g);
        if (c + 1 < NCH) { asm volatile("s_waitcnt vmcnt(0)" ::: "memory"); cscan_psum(F, c + 1); }
        if (odp) *(v2u*)(ODb + odo) = odv;
        if (bsp && (l & 15) == 0) BS[bsidx] = bsval;
        CS_BAR();
        if constexpr (SOLVER) cs_solve(L, w, l);
        bsp = false;
        if (c + 1 < NCH) {
            cscan_rawread<DIR>(F, c + 1, raw);
#pragma unroll
            for (int jj = 0; jj < CS_SPW; ++jj) knC[jj] = knN[jj];
            asm volatile("s_waitcnt lgkmcnt(0)" ::: "memory");
            if (c + 2 < NCH) cscan_dma<DIR>(F, b, h, c + 2, knN);
            cscan_stage<DIR>(F, b, h, c + 1, raw, knC, KC, L + ((c + 1) & 1) * CS_SET, bsval, bsidx);
            bsp = (c + 1) >= CL / SC_TS;
        }
        CS_BAR();
        cs_phase4<DIR>(L, set, S0, S0n, Sacc, w, il, g, c, b, h, odv, odo);
        odp = c >= CL / SC_TS;
        CS_BAR();
    }
    if (odp) *(v2u*)(ODb + odo) = odv;
}
template <int DIR> __device__ __forceinline__ void cscan_body(Frame& F, int b, int h) {
    for (int q = F.tid; q < 9216 / 4; q += NTHR) ((LAS unsigned*)(F.lds + CS_S0A))[q] = 0u;
    if (F.wave >= 4) cscan_loop<DIR, false>(F, b, h); else cscan_loop<DIR, true>(F, b, h);
    asm volatile("s_waitcnt vmcnt(0)" ::: "memory");
}
__device__ __forceinline__ void p6_scan(Frame& F) {
    for (int it = F.bid; it < NB * WH * 2; it += F.G) {
        const int d = it & 1, h = (it >> 1) & 7, b = it >> 4;
        if (d == 0) cscan_body<0>(F, b, h); else cscan_body<1>(F, b, h);
        __syncthreads();
    }
}

struct MpLoads { v2u of[4], ob[4], vc[4], vp[4], vn[4]; float bs0, bs1; };
__device__ __forceinline__ void mp_load(MpLoads& m, const bf16* OF, const bf16* OB, const bf16* Z2, const float* BS, int row, int hh, int g, bool hp, bool hn) {
#pragma unroll
    for (int ntl = 0; ntl < 4; ++ntl) { const int ch0 = 64 * hh + 16 * ntl + 4 * g;
        { const size_t bo = ((size_t)(row >> 4) * 8 + hh) * 1024 + ntl * 256 + ((g >> 1) * 16 + (row & 15)) * 8 + (g & 1) * 4; m.of[ntl] = *(const v2u*)(OF + bo); m.ob[ntl] = *(const v2u*)(OB + bo); }
        { const int c = 2 * ntl + (g >> 1), ho = (g & 1) * 4;
          m.vc[ntl] = *(const v2u*)(Z2 + vblk_off(row, hh, c) + ho);
          m.vp[ntl] = *(const v2u*)(Z2 + vblk_off(row - (hp ? 1 : 0), hh, c) + ho); m.vn[ntl] = *(const v2u*)(Z2 + vblk_off(row + (hn ? 1 : 0), hh, c) + ho); } }
    m.bs0 = BS[(size_t)row * 8 + hh]; m.bs1 = BS[((size_t)NTOK + row) * 8 + hh];
}
__device__ __forceinline__ void p7_mergeprep(Frame& F) {
    using pg8::bf16x8;
    const int gw = F.bid * NWAVES + F.wave, NGW = F.G * NWAVES;
    const bf16* Z2 = (const bf16*)(F.ws + WS_Z2);
    const bf16* OF = (const bf16*)(F.ws + WS_OF); const bf16* OB = (const bf16*)(F.ws + WS_OB); const float* BS = (const float*)(F.ws + SM_BS);
    const bf16* G2T = (const bf16*)(F.ws + SM_G2T);
    bf16* ARW = (bf16*)(F.ws + WS_ARW);
    const float* mu = F.in[I_MU]; const float* lng = F.in[I_LNG]; const float* lnb = F.in[I_LNB];
    const int l = F.lane, i = l & 15, g = l >> 4;
    __syncthreads();
    { v4u t16[16];
#pragma unroll
      for (int q = 0; q < 16; ++q) { const int idx = F.tid + NTHR * q; t16[q] = *(const v4u*)(G2T + (size_t)(idx >> 4) * 128 + (idx & 15) * 8); }
#pragma unroll
      for (int q = 0; q < 16; ++q) { const int idx = F.tid + NTHR * q, r = idx >> 4, c = idx & 15; *(LAS v4u*)(F.lds + (r * 16 + (c ^ (r & 15))) * 16) = t16[q]; } }
    LAS float* CV = (LAS float*)(F.lds + 131072);
    { const int k = F.tid; CV[k] = mu[512 + k]; CV[512 + k] = mu[1792 + 512 + k]; CV[1024 + k] = lng[k]; CV[1536 + k] = lnb[k]; if (k < 128) { CV[2048 + k] = mu[1664 + k]; CV[2176 + k] = mu[1792 + 1664 + k]; } }
    __syncthreads();
    for (int task = gw; task < NTOK / 16; task += NGW) {
        const int row = task * 16 + i; bool hp, hn; row_bounds(row, hp, hn);
        bf16x8 Bg[4];
        Sh3 sg[4];
#pragma unroll
        for (int ks = 0; ks < 4; ++ks) shift_load_blk(sg[ks], Z2, row, 4 + ks, g, hp, hn);
        MpLoads nx; mp_load(nx, OF, OB, Z2, BS, row, 0, g, hp, hn);
        __builtin_amdgcn_sched_barrier(0);
#pragma unroll
        for (int ks = 0; ks < 4; ++ks) { float v[8], m0g[8], m1g[8]; lds8(CV + 2048 + 32 * ks + 8 * g, m0g); lds8(CV + 2176 + 32 * ks + 8 * g, m1g);
            shift_apply(sg[ks], hp, hn, m0g, m1g, v);
#pragma unroll
            for (int e = 0; e < 8; ++e) v[e] = sigmoidf_(v[e]);
            Bg[ks] = pack8(v); }
#pragma unroll 1
        for (int hh = 0; hh < 8; ++hh) {
            const MpLoads cur = nx;
            if (hh + 1 < 8) mp_load(nx, OF, OB, Z2, BS, row, hh + 1, g, hp, hn);
            f32x4 G[4], oo[4]; float s1 = 0.f;
#pragma unroll
            for (int ntl = 0; ntl < 4; ++ntl) { const int nt = 4 * hh + ntl;
                f32x4 acc = (f32x4){0.f, 0.f, 0.f, 0.f};
#pragma unroll
                for (int ks = 0; ks < 4; ++ks) { const bf16x8 af = *(const LAS bf16x8*)(F.lds + ((16 * nt + i) * 16 + ((4 * ks + g) ^ i)) * 16);
                    acc = __builtin_amdgcn_mfma_f32_16x16x32_bf16(af, Bg[ks], acc, 0, 0, 0); }
                G[ntl] = acc;
                const v2u a = cur.of[ntl], b2 = cur.ob[ntl];
                oo[ntl] = (f32x4){bflo(a.x) + bflo(b2.x), bfhi(a.x) + bfhi(b2.x), bflo(a.y) + bflo(b2.y), bfhi(a.y) + bfhi(b2.y)};
                s1 += (oo[ntl][0] + oo[ntl][1]) + (oo[ntl][2] + oo[ntl][3]); }
            s1 = swap16_add(s1, s1); s1 = swap32_add(s1, s1);
            const float mean = s1 * (1.f / 64.f); float s2 = 0.f;
#pragma unroll
            for (int ntl = 0; ntl < 4; ++ntl) { oo[ntl] = oo[ntl] - mean; s2 += (oo[ntl][0] * oo[ntl][0] + oo[ntl][1] * oo[ntl][1]) + (oo[ntl][2] * oo[ntl][2] + oo[ntl][3] * oo[ntl][3]); }
            s2 = swap16_add(s2, s2); s2 = swap32_add(s2, s2);
            const float rstd = __builtin_amdgcn_rsqf(s2 * (1.f / 64.f) + 64e-5f);
            const float bon = cur.bs0 + cur.bs1;
#pragma unroll
            for (int ntl = 0; ntl < 4; ++ntl) { const int ch0 = 64 * hh + 16 * ntl + 4 * g;
                const v2u zero2 = (v2u){0u, 0u};
                const v2u vc = cur.vc[ntl], vp = hp ? cur.vp[ntl] : zero2, vn = hn ? cur.vn[ntl] : zero2;
                const f32x4 m0 = *(const LAS f32x4*)(CV + ch0), m1 = *(const LAS f32x4*)(CV + 512 + ch0), lg4 = *(const LAS f32x4*)(CV + 1024 + ch0), lb4 = *(const LAS f32x4*)(CV + 1536 + ch0);
                const f32x4 cf = (f32x4){bflo(vc.x), bfhi(vc.x), bflo(vc.y), bfhi(vc.y)}, pf = (f32x4){bflo(vp.x), bfhi(vp.x), bflo(vp.y), bfhi(vp.y)}, nf = (f32x4){bflo(vn.x), bfhi(vn.x), bflo(vn.y), bfhi(vn.y)};
                const f32x4 vs = cf + m0 * (pf - cf) + m1 * (nf - cf);
                const f32x4 y = oo[ntl] * rstd * lg4 + lb4;
                const f32x4 r = (y + vs * bon) * G[ntl];
                v2u ww; ww.x = pk2(r[0], r[1]); ww.y = pk2(r[2], r[3]);
                *(v2u*)(ARW + (size_t)row * 512 + ch0) = ww; }
        }
    }
    __syncthreads();
}

struct SchedDense {
    int nM, nN, G, c, K; const char* A; const char* Bt;
    __device__ __forceinline__ bool next(int i, pg8::Unit& u) const {
        const int L = i * G + c; if (L >= nM * nN) return false;
        const int per = 8 * nN, g = L / per, rem = L % per; u.pn = rem >> 3; u.pm = g * 8 + (rem & 7); return true;
    }
    __device__ __forceinline__ const char* a_base(const pg8::Unit& u) const { return A + (size_t)u.pm * 256 * K * 2; }
    __device__ __forceinline__ const char* b_base(const pg8::Unit& u) const { return Bt + (size_t)u.pn * 256 * K * 2; }
};
template <bool ADD> struct EpiMix {
    bf16* MIX; const bf16* Z6; int goff;
    __device__ __forceinline__ void operator()(const pg8::f32x4 (&acc)[2][2][4][2], const pg8::Unit& u, int wr, int wc, int fr, int fq) const {
        const int row0 = u.pm * 256 + wr * 64 + fr, col0 = u.pn * 256 + wc * 32 + 8 * fq;
#pragma unroll
        for (int ai = 0; ai < 2; ++ai)
#pragma unroll
            for (int m = 0; m < 4; ++m) { const int row = row0 + ai * 128 + m * 16;
#pragma unroll
                for (int bj = 0; bj < 2; ++bj) { const int col = col0 + bj * 128;
                    const v4u gz = *(const v4u*)(Z6 + ((size_t)u.pm * 8 + (goff >> 8) + u.pn) * 65536 + ((((ai * 4 + m) * 2 + bj) * 8) + wr * 4 + wc) * 512 + (fq * 16 + fr) * 8);
                    const pg8::f32x4 a0 = acc[ai][bj][m][0], a1 = acc[ai][bj][m][1];
                    float r[8];
                    r[0] = sigmoidf_(bflo(gz.x)) * a0[0]; r[1] = sigmoidf_(bfhi(gz.x)) * a0[1]; r[2] = sigmoidf_(bflo(gz.y)) * a0[2]; r[3] = sigmoidf_(bfhi(gz.y)) * a0[3];
                    r[4] = sigmoidf_(bflo(gz.z)) * a1[0]; r[5] = sigmoidf_(bfhi(gz.z)) * a1[1]; r[6] = sigmoidf_(bflo(gz.w)) * a1[2]; r[7] = sigmoidf_(bfhi(gz.w)) * a1[3];
                    bf16* dst = MIX + (size_t)row * 1024 + col;
                    if (ADD) { const v4u o = *(const v4u*)dst;
                        r[0] += bflo(o.x); r[1] += bfhi(o.x); r[2] += bflo(o.y); r[3] += bfhi(o.y); r[4] += bflo(o.z); r[5] += bfhi(o.z); r[6] += bflo(o.w); r[7] += bfhi(o.w); }
                    v4u w; w.x = pg8::cvt_pk_bf16(r[0], r[1]); w.y = pg8::cvt_pk_bf16(r[2], r[3]); w.z = pg8::cvt_pk_bf16(r[4], r[5]); w.w = pg8::cvt_pk_bf16(r[6], r[7]);
                    *(v4u*)dst = w; } }
    }
};
struct EpiBf16 {
    bf16* O; int ldc;
    __device__ __forceinline__ void operator()(const pg8::f32x4 (&acc)[2][2][4][2], const pg8::Unit& u, int wr, int wc, int fr, int fq) const {
        const int row0 = u.pm * 256 + wr * 64 + fr, col0 = u.pn * 256 + wc * 32 + 8 * fq;
#pragma unroll
        for (int ai = 0; ai < 2; ++ai)
#pragma unroll
            for (int m = 0; m < 4; ++m) { bf16* rowp = O + (size_t)(row0 + ai * 128 + m * 16) * ldc + col0;
#pragma unroll
                for (int bj = 0; bj < 2; ++bj) { const pg8::f32x4 v0 = acc[ai][bj][m][0], v1 = acc[ai][bj][m][1];
                    v4u w; w.x = pg8::cvt_pk_bf16(v0[0], v0[1]); w.y = pg8::cvt_pk_bf16(v0[2], v0[3]); w.z = pg8::cvt_pk_bf16(v1[0], v1[1]); w.w = pg8::cvt_pk_bf16(v1[2], v1[3]);
                    *(v4u*)(rowp + bj * 128) = w; } }
    }
};

__device__ __forceinline__ void p11_rowpass(Frame& F) {
    const int gw = F.bid * NWAVES + F.wave, NGW = F.G * NWAVES;
    {
        LAS float* scr = (LAS float*)(F.lds + F.wave * 16384);
        unsigned char* WGU = F.ws + WS_WGU; unsigned char* WDN = F.ws + WS_WDN;
        constexpr int I_GU = 16 * 64, I_DN = 16 * 32, NIT = NE * (I_GU + I_DN);
#define MOE_ITEM(it, SRC, LDN, SCOL, K0, DST, DROW) do { const int e_ = (it) / (I_GU + I_DN); int r_ = (it) % (I_GU + I_DN); \
        if (r_ < I_GU) { const int kb = r_ / 64, nb = r_ % 64; DROW = 32 * nb; const int j = DROW >> 8, w_ = DROW & 255; \
            SRC = ((w_ < 128) ? F.in[I_WGATE] : F.in[I_WUP]) + (size_t)e_ * 1024 * 1024; SCOL = j * 128 + (w_ & 127); K0 = 64 * kb; DST = WGU + (size_t)e_ * 2048 * 1024; } \
        else { r_ -= I_GU; const int kb = r_ / 32, nb = r_ % 32; DROW = 32 * nb; SRC = F.in[I_WDOWN] + (size_t)e_ * 1024 * 1024; SCOL = 32 * nb; K0 = 64 * kb; DST = WDN + (size_t)e_ * 1024 * 1024; } } while (0)
        f32x4 va[8], vb[8];
        const float* srcA; int scolA, k0A, drowA; unsigned char* dstA;
        int it = gw;
        if (it < NIT) { MOE_ITEM(it, srcA, 0, scolA, k0A, dstA, drowA); transpose_load(va, srcA, 1024, scolA, k0A, F.lane); }
        while (it < NIT) {
            const int it2 = it + NGW; const float* srcB = srcA; int scolB = scolA, k0B = k0A, drowB = drowA; unsigned char* dstB = dstA;
            if (it2 < NIT) { MOE_ITEM(it2, srcB, 0, scolB, k0B, dstB, drowB); transpose_load(vb, srcB, 1024, scolB, k0B, F.lane); }
            transpose_finish_f8(va, 1024, dstA, drowA, k0A, scr, F.lane, F8_WSCALE);
#pragma unroll
            for (int q = 0; q < 8; ++q) va[q] = vb[q];
            srcA = srcB; scolA = scolB; k0A = k0B; drowA = drowB; dstA = dstB; it = it2;
        }
#undef MOE_ITEM
    }
    const float* MOD = (const float*)(F.ws + SM_MOD); const float* ng = F.in[I_NORMG]; const float* wr_ = F.in[I_WROUTER];
    const bf16* YL = (const bf16*)(F.ws + WS_YLAT); bf16* H2 = (bf16*)(F.ws + WS_H2); float* AFF = (float*)(F.ws + SM_AFF);
    LAS float* WRT = (LAS float*)(F.lds);
    __syncthreads();
    { const float* wrt = (const float*)(F.ws + SM_WRT); f32x4 t8[8];
#pragma unroll
      for (int q = 0; q < 8; ++q) t8[q] = *(const f32x4*)(wrt + 4 * (F.tid + NTHR * q));
#pragma unroll
      for (int q = 0; q < 8; ++q) *(LAS f32x4*)(WRT + 4 * (F.tid + NTHR * q)) = t8[q]; }
    __syncthreads();
    const int ln = F.lane;
    for (int r0 = gw * 16; r0 < NTOK; r0 += NGW * 16) {
        const int b = r0 / T, t0 = r0 % T;
        const float* mod = MOD + b * NMODC;
        f32x4 G1[4], N2S[4], SH[4];
#pragma unroll
        for (int j = 0; j < 4; ++j) { const int k = 4 * ln + 256 * j;
            G1[j] = *(const f32x4*)(mod + 2048 + k) * *(const f32x4*)(ng + 1024 + k);
            N2S[j] = *(const f32x4*)(ng + 2048 + k) * (*(const f32x4*)(mod + 4096 + k) + 1.f); SH[j] = *(const f32x4*)(mod + 3072 + k); }
        v2u yn[2][4]; f32x4 xn[2][4];
#pragma unroll
        for (int r = 0; r < 2; ++r)
#pragma unroll
            for (int j = 0; j < 4; ++j) { yn[r][j] = __builtin_nontemporal_load((const GAS v2u*)(YL + (size_t)(r0 + r) * D) + ln + 64 * j); xn[r][j] = __builtin_nontemporal_load((const f32x4*)(F.in[I_X] + (size_t)(r0 + r) * D + 4 * ln + 256 * j)); }
#pragma unroll 1
        for (int pr = 0; pr < 8; ++pr) {
            const int m = r0 + 2 * pr;
            v2u yc[2][4]; f32x4 x1[2][4];
#pragma unroll
            for (int r = 0; r < 2; ++r)
#pragma unroll
                for (int j = 0; j < 4; ++j) { yc[r][j] = yn[r][j]; x1[r][j] = xn[r][j]; }
            { const int m2 = pr + 1 < 8 ? m + 2 : m;
#pragma unroll
              for (int r = 0; r < 2; ++r)
#pragma unroll
                  for (int j = 0; j < 4; ++j) { yn[r][j] = __builtin_nontemporal_load((const GAS v2u*)(YL + (size_t)(m2 + r) * D) + ln + 64 * j); xn[r][j] = __builtin_nontemporal_load((const f32x4*)(F.in[I_X] + (size_t)(m2 + r) * D + 4 * ln + 256 * j)); } }
            float rstd[2], rstd2[2];
#pragma unroll
            for (int r = 0; r < 2; ++r) { float ss = 0.f;
#pragma unroll
                for (int j = 0; j < 4; ++j) { const v2u w = yc[r][j]; const float a = bflo(w.x), c = bfhi(w.x), d = bflo(w.y), e = bfhi(w.y); ss += (a * a + c * c) + (d * d + e * e); }
                rstd[r] = __builtin_amdgcn_rsqf(wave_sum(ss) * (1.f / D) + NORM_EPS); }
#pragma unroll
            for (int r = 0; r < 2; ++r) { float s2 = 0.f;
#pragma unroll
                for (int j = 0; j < 4; ++j) { const int k = 4 * ln + 256 * j; const v2u w = yc[r][j];
                    const f32x4 y = (f32x4){bflo(w.x), bfhi(w.x), bflo(w.y), bfhi(w.y)};
                    x1[r][j] = x1[r][j] + G1[j] * (y * rstd[r]);
                    { v2u xw; xw.x = pk2(x1[r][j].x, x1[r][j].y); xw.y = pk2(x1[r][j].z, x1[r][j].w); __builtin_nontemporal_store(xw, (v2u*)((bf16*)(F.out + (size_t)(m + r) * D) + k)); }
                    s2 += (x1[r][j].x * x1[r][j].x + x1[r][j].y * x1[r][j].y) + (x1[r][j].z * x1[r][j].z + x1[r][j].w * x1[r][j].w); }
                rstd2[r] = __builtin_amdgcn_rsqf(wave_sum(s2) * (1.f / D) + NORM_EPS); }
            float lg[2][16];
#pragma unroll
            for (int e = 0; e < 16; ++e) { lg[0][e] = 0.f; lg[1][e] = 0.f; }
#pragma unroll
            for (int j = 0; j < 4; ++j) { const int k = 4 * ln + 256 * j;
                const f32x4 h0 = x1[0][j] * rstd2[0] * N2S[j] + SH[j], h1 = x1[1][j] * rstd2[1] * N2S[j] + SH[j];
                *(unsigned*)((unsigned char*)H2 + (size_t)m * D + k) = f8x4(h0.x, h0.y, h0.z, h0.w);
                *(unsigned*)((unsigned char*)H2 + (size_t)(m + 1) * D + k) = f8x4(h1.x, h1.y, h1.z, h1.w);
#pragma unroll
                for (int e = 0; e < 16; ++e) { const f32x4 wv = *(const LAS f32x4*)(WRT + e * 1024 + k);
                    lg[0][e] = __builtin_fmaf(h0.w, wv.w, __builtin_fmaf(h0.z, wv.z, __builtin_fmaf(h0.y, wv.y, __builtin_fmaf(h0.x, wv.x, lg[0][e]))));
                    lg[1][e] = __builtin_fmaf(h1.w, wv.w, __builtin_fmaf(h1.z, wv.z, __builtin_fmaf(h1.y, wv.y, __builtin_fmaf(h1.x, wv.x, lg[1][e]))));
                    if ((e & 7) == 7) __builtin_amdgcn_sched_barrier(0); } }
            float t2[8];
#pragma unroll
            for (int e = 0; e < 8; ++e) t2[e] = swap16_add(swap32_add(lg[0][e], lg[1][e]), swap32_add(lg[0][e + 8], lg[1][e + 8]));
            const bool b3 = (ln & 8) != 0, b2 = (ln & 4) != 0, b1 = (ln & 2) != 0;
            float t3[4];
#pragma unroll
            for (int i2 = 0; i2 < 4; ++i2) { const float keep = b3 ? t2[i2 + 4] : t2[i2], send = b3 ? t2[i2] : t2[i2 + 4]; t3[i2] = keep + dpp_f<0x128>(send); }
            float t4[2];
#pragma unroll
            for (int i2 = 0; i2 < 2; ++i2) { const float keep = b2 ? t3[i2 + 2] : t3[i2], send = b2 ? t3[i2] : t3[i2 + 2]; t4[i2] = keep + dpp_xor4(send); }
            float lgt; { const float keep = b1 ? t4[1] : t4[0], send = b1 ? t4[0] : t4[1]; lgt = keep + dpp_f<0x4E>(send); }
            lgt += dpp_f<0xB1>(lgt);
            float mx = lgt; mx = fmaxf(mx, dpp_f<0x4E>(mx)); mx = fmaxf(mx, dpp_f<0x141>(mx)); mx = fmaxf(mx, dpp_f<0x140>(mx)); mx = swap16_max(mx);
            const float ex = expf(lgt - mx);
            float se = ex; se += dpp_f<0x4E>(se); se += dpp_f<0x141>(se); se += dpp_f<0x140>(se); se = swap16_add(se, se);
            if ((ln & 1) == 0) AFF[((size_t)(b * NE + ((ln >> 1) & 15))) * T + (t0 + 2 * pr + (ln >> 5))] = ex / se;
        }
    }
}

__device__ __forceinline__ void p12_topk(Frame& F) {
    LAS int* wtot = (LAS int*)(F.lds);
    const float* AFF = (const float*)(F.ws + SM_AFF); int* IDX = (int*)(F.ws + SM_IDX); float* GATE = (float*)(F.ws + SM_GATE); int* SEL = (int*)(F.ws + SM_SEL);
    const int l = F.lane, w = F.wave;
    for (int be = F.bid; be < NB * NE; be += F.G) {
        const float* av = AFF + (size_t)be * T;
        unsigned vb[32];
#pragma unroll
        for (int j = 0; j < 8; ++j) { const v4u x = *(const v4u*)(av + 4 * (l + 64 * j)); vb[4 * j] = x.x; vb[4 * j + 1] = x.y; vb[4 * j + 2] = x.z; vb[4 * j + 3] = x.w; }
        unsigned thr = 0u;
        for (int bit = 30; bit >= 0; --bit) { const unsigned cand = thr | (1u << bit); int c = 0;
#pragma unroll
            for (int q = 0; q < 32; ++q) c += (vb[q] >= cand) ? 1 : 0;
            c = (int)wave_sum_dpp((float)c);
            if (c >= CAP) thr = cand; }
        int cg = 0;
#pragma unroll
        for (int q = 0; q < 32; ++q) cg += (vb[q] > thr) ? 1 : 0;
        const int cnt_gt = (int)wave_sum_dpp((float)cg), need_eq = CAP - cnt_gt;
        const v4u mine = *(const v4u*)(av + 4 * F.tid); const unsigned mv[4] = {mine.x, mine.y, mine.z, mine.w};
        int ngt = 0, neq = 0;
#pragma unroll
        for (int q = 0; q < 4; ++q) { ngt += mv[q] > thr ? 1 : 0; neq += mv[q] == thr ? 1 : 0; }
        int sgt = ngt, seq = neq;
#pragma unroll
        for (int o = 1; o < 64; o <<= 1) { const int a = __shfl_up(sgt, o), b2 = __shfl_up(seq, o); if (l >= o) { sgt += a; seq += b2; } }
        if (l == 63) { wtot[2 * w] = sgt; wtot[2 * w + 1] = seq; }
        __syncthreads();
        int ogt = 0, oeq = 0;
        for (int q = 0; q < w; ++q) { ogt += wtot[2 * q]; oeq += wtot[2 * q + 1]; }
        int rgt = ogt + sgt - ngt, req = oeq + seq - neq;
#pragma unroll
        for (int q = 0; q < 4; ++q) { const int ti = 4 * F.tid + q; int slot = -1;
            if (mv[q] > thr) { slot = rgt; ++rgt; } else if (mv[q] == thr) { if (req < need_eq) slot = cnt_gt + req; ++req; }
            SEL[(size_t)be * T + ti] = slot;
            if (slot >= 0) { IDX[be * CAP + slot] = ti; GATE[be * CAP + slot] = __builtin_bit_cast(float, mv[q]); } }
        __syncthreads();
    }
}

__device__ __forceinline__ void p13_gather(Frame& F) {
    const int gw = F.bid * NWAVES + F.wave, NGW = F.G * NWAVES;
    const int* IDX = (const int*)(F.ws + SM_IDX); const bf16* H2 = (const bf16*)(F.ws + WS_H2); bf16* XG = (bf16*)(F.ws + WS_XG);
    for (int r0 = gw * 4; r0 < NB * NE * CAP; r0 += NGW * 4) {
        int tok[4]; v4u a[4], c[4];
#pragma unroll
        for (int q = 0; q < 4; ++q) tok[q] = IDX[r0 + q];
#pragma unroll
        for (int q = 0; q < 4; ++q) { const int b = (r0 + q) / (NE * CAP); const GAS v4u* src = (const GAS v4u*)(H2 + ((size_t)b * T + tok[q]) * D) + F.lane; a[q] = src[0]; c[q] = src[64]; }
#pragma unroll
        for (int q = 0; q < 4; ++q) { GAS v4u* dst = (GAS v4u*)(XG + (size_t)(r0 + q) * D) + F.lane; dst[0] = a[q]; dst[64] = c[q]; }
    }
}

struct SchedUp {
    int G, c; const char* A; const char* Bt;
    __device__ __forceinline__ bool next(int i, pg8::Unit& u) const {
        const int L = i * G + c; if (L >= 2048) return false;
        const int rnd = L >> 8, cc = L & 255;
        if (G == 256) { const int x = cc & 7, k = cc >> 3; u.pm = ((x >> 1) * 4 + (k >> 3)) * NE + 2 * rnd + (x & 1); u.pn = k & 7; return true; }
        const int b = cc >> 4, e = 2 * rnd + ((cc & 15) >> 3); u.pm = b * NE + e; u.pn = cc & 7; return true;
    }
    const int* IDX;
    __device__ __forceinline__ const char* a_base(const pg8::Unit&) const { return A; }
    __device__ __forceinline__ const char* a_root() const { return A; }
    __device__ __forceinline__ const char* b_root() const { return Bt; }
    __device__ __forceinline__ unsigned a_off(const pg8::Unit&) const { return 0u; }
    __device__ __forceinline__ unsigned b_off(const pg8::Unit& u) const { return (unsigned)(((u.pm & 15) * 2048 + u.pn * 256) * 1024); }
    __device__ __forceinline__ unsigned a_rowoff(const pg8::Unit& u, int r) const { return (unsigned)(((u.pm >> 4) * T + IDX[u.pm * CAP + r]) * D); }
    __device__ __forceinline__ const char* b_base(const pg8::Unit& u) const { return Bt + ((size_t)(u.pm & 15) * 2048 + (size_t)u.pn * 256) * 1024; }
};
struct EpiUp {
    unsigned char* HID;
    __device__ __forceinline__ void operator()(const pg8::f32x4 (&acc)[2][2][4][2], const pg8::Unit& u, int wr, int wc, int fr, int fq) const {
        const int row0 = u.pm * 256 + wr * 64 + fr, col0 = u.pn * 128 + wc * 32 + 8 * fq;
        constexpr float iw = 1.f / F8_WSCALE, ho = F8_HSCALE / F8_WSCALE;
#pragma unroll
        for (int ai = 0; ai < 2; ++ai)
#pragma unroll
            for (int m = 0; m < 4; ++m) { unsigned char* rowp = HID + (size_t)(row0 + ai * 128 + m * 16) * FF + col0;
                const pg8::f32x4 g0 = acc[ai][0][m][0] * iw, g1 = acc[ai][0][m][1] * iw, u0 = acc[ai][1][m][0] * ho, u1 = acc[ai][1][m][1] * ho;
                v2u w; w.x = f8x4(siluf_(g0[0]) * u0[0], siluf_(g0[1]) * u0[1], siluf_(g0[2]) * u0[2], siluf_(g0[3]) * u0[3]);
                w.y = f8x4(siluf_(g1[0]) * u1[0], siluf_(g1[1]) * u1[1], siluf_(g1[2]) * u1[2], siluf_(g1[3]) * u1[3]);
                *(v2u*)rowp = w; }
    }
};
struct SchedDown {
    int G, c; const char* A; const char* Bt;
    __device__ __forceinline__ bool next(int i, pg8::Unit& u) const {
        const int L = i * G + c; if (L >= 1024) return false;
        const int rnd = L >> 8, cc = L & 255;
        if (G == 256) { const int x = cc & 7, k = cc >> 3; u.pm = ((x >> 2) * 8 + (k >> 2)) * NE + 4 * rnd + (x & 3); u.pn = k & 3; return true; }
        const int b = cc >> 4, e = 4 * rnd + ((cc & 15) >> 2); u.pm = b * NE + e; u.pn = cc & 3; return true;
    }
    __device__ __forceinline__ const char* a_root() const { return A; }
    __device__ __forceinline__ const char* b_root() const { return Bt; }
    __device__ __forceinline__ unsigned a_off(const pg8::Unit& u) const { return (unsigned)(u.pm * 256 * 1024); }
    __device__ __forceinline__ unsigned b_off(const pg8::Unit& u) const { return (unsigned)(((u.pm & 15) * 1024 + u.pn * 256) * 1024); }
    __device__ __forceinline__ const char* a_base(const pg8::Unit& u) const { return A + (size_t)u.pm * 256 * 1024; }
    __device__ __forceinline__ const char* b_base(const pg8::Unit& u) const { return Bt + ((size_t)(u.pm & 15) * 1024 + (size_t)u.pn * 256) * 1024; }
};
struct EpiDown {
    bf16* Y; const float* GATE;
    __device__ __forceinline__ void operator()(const pg8::f32x4 (&acc)[2][2][4][2], const pg8::Unit& u, int wr, int wc, int fr, int fq) const {
        const int row0 = u.pm * 256 + wr * 64 + fr, col0 = u.pn * 256 + wc * 32 + 8 * fq;
#pragma unroll
        for (int ai = 0; ai < 2; ++ai)
#pragma unroll
            for (int m = 0; m < 4; ++m) { const int row = row0 + ai * 128 + m * 16; const float gt = GATE[row] * (1.f / (F8_WSCALE * F8_HSCALE)); bf16* rowp = Y + (size_t)row * D + col0;
#pragma unroll
                for (int bj = 0; bj < 2; ++bj) { const pg8::f32x4 v0 = acc[ai][bj][m][0] * gt, v1 = acc[ai][bj][m][1] * gt;
                    v4u w; w.x = pg8::cvt_pk_bf16(v0[0], v0[1]); w.y = pg8::cvt_pk_bf16(v0[2], v0[3]); w.z = pg8::cvt_pk_bf16(v1[0], v1[1]); w.w = pg8::cvt_pk_bf16(v1[2], v1[3]);
                    *(v4u*)(rowp + bj * 128) = w; } }
    }
};

__device__ __forceinline__ void p16_final(Frame& F) {
    int ln; asm volatile("v_mbcnt_lo_u32_b32 %0, -1, 0\n\tv_mbcnt_hi_u32_b32 %0, -1, %0" : "=v"(ln));
    const int gw = F.bid * NWAVES + F.wave, NGW = F.G * NWAVES;
    const float* MOD = (const float*)(F.ws + SM_MOD); const float* ng = F.in[I_NORMG];
    const int* SEL = (const int*)(F.ws + SM_SEL); const bf16* Y = (const bf16*)(F.ws + WS_Y);
    const bf16* ZROW = (const bf16*)(F.ws + WS_CTL + 40 * 1024);
    for (int r0 = gw * 16; r0 < NTOK; r0 += NGW * 16) {
        const int b = r0 / T, t0 = r0 % T;
        f32x4 G2N3[4];
#pragma unroll
        for (int j = 0; j < 4; ++j) { const int k = 4 * ln + 256 * j; G2N3[j] = *(const f32x4*)(MOD + b * NMODC + 5120 + k) * *(const f32x4*)(ng + 3072 + k); }
        int yrowv[4]; unsigned long long bm[4];
#pragma unroll
        for (int q = 0; q < 4; ++q) { const int e = ln & 15, i = ln >> 4; const int sv = SEL[(size_t)(b * NE + e) * T + t0 + 4 * q + i];
            yrowv[q] = (b * NE + e) * CAP + sv; bm[q] = __builtin_amdgcn_ballot_w64(sv >= 0); }
        v2u yv[2][4][4]; v2u xv[2][4]; unsigned rem[2];
#define P16_ISSUE(r) do { const int q_ = (r) >> 2, i_ = (r) & 3, bf_ = (r) & 1; unsigned mk_ = (unsigned)(bm[q_] >> (16 * i_)) & 0xffffu; \
            _Pragma("unroll") for (int k_ = 0; k_ < 4; ++k_) { const bf16* src_ = ZROW; \
                if (mk_) { const int e_ = __builtin_ctz(mk_); mk_ &= mk_ - 1u; src_ = Y + (size_t)__builtin_amdgcn_readlane(yrowv[q_], 16 * i_ + e_) * D; } \
                _Pragma("unroll") for (int j = 0; j < 4; ++j) yv[bf_][k_][j] = __builtin_nontemporal_load((const GAS v2u*)src_ + ln + 64 * j); } \
            rem[bf_] = mk_; \
            _Pragma("unroll") for (int j = 0; j < 4; ++j) xv[bf_][j] = *(const v2u*)((const bf16*)(F.out + (size_t)(r0 + (r)) * D) + 4 * ln + 256 * j); } while (0)
        P16_ISSUE(0);
#pragma unroll
        for (int r = 0; r < 16; ++r) {
            if (r + 1 < 16) P16_ISSUE(r + 1);
            const int bf = r & 1, q = r >> 2, i = r & 3;
            f32x4 a[4];
#pragma unroll
            for (int j = 0; j < 4; ++j) { a[j] = (f32x4){0.f, 0.f, 0.f, 0.f};
#pragma unroll
                for (int k = 0; k < 4; ++k) { const v2u w = yv[bf][k][j]; a[j] += (f32x4){bflo(w.x), bfhi(w.x), bflo(w.y), bfhi(w.y)}; } }
            for (unsigned mk = rem[bf]; mk; mk &= mk - 1u) { const int e = __builtin_ctz(mk);
                const GAS v2u* yp = (const GAS v2u*)(Y + (size_t)__builtin_amdgcn_readlane(yrowv[q], 16 * i + e) * D) + ln;
#pragma unroll
                for (int j = 0; j < 4; ++j) { const v2u w = yp[64 * j]; a[j] += (f32x4){bflo(w.x), bfhi(w.x), bflo(w.y), bfhi(w.y)}; } }
            float ss = 0.f;
#pragma unroll
            for (int j = 0; j < 4; ++j) ss += (a[j].x * a[j].x + a[j].y * a[j].y) + (a[j].z * a[j].z + a[j].w * a[j].w);
            const float rstd = __builtin_amdgcn_rsqf(wave_sum(ss) * (1.f / D) + NORM_EPS);
#pragma unroll
            for (int j = 0; j < 4; ++j) { const v2u xw = xv[bf][j]; __builtin_nontemporal_store((f32x4){bflo(xw.x), bfhi(xw.x), bflo(xw.y), bfhi(xw.y)} + G2N3[j] * (a[j] * rstd), (f32x4*)(F.out + (size_t)(r0 + r) * D + 4 * ln + 256 * j)); }
        }
#undef P16_ISSUE
    }
}

constexpr int NPHASE = 17;
__global__ void __launch_bounds__(NTHR, 2) mk_fwd(Args args) {
    extern __shared__ __attribute__((aligned(16))) unsigned char lds[];
    Frame F;
    F.lds = (LAS unsigned char*)lds;
    F.tid = threadIdx.x; F.lane = F.tid & 63; F.wave = __builtin_amdgcn_readfirstlane(F.tid >> 6);
    F.G = gridDim.x; F.bid = blockIdx.x;
    F.in = args.in; F.out = args.out; F.ws = args.ws;
    volatile LAS unsigned* MISC = (volatile LAS unsigned*)(F.lds + MISC_OFF);
    for (int u = F.tid; u < (LDS_BYTES - LDSCTL_OFF) / 4; u += NTHR) ((LAS unsigned*)(F.lds + LDSCTL_OFF))[u] = 0u;
    __syncthreads();
    XcdBarrier bar; bar.bar = (unsigned*)(args.ws + WS_CTL) + CW_BAR; bar.x = 0; bar.st = nullptr;
    const int lo = args.ph_lo, hi = args.ph_hi;
    if (hi - lo > 1) bar = xcd_barrier_post((unsigned*)(args.ws + WS_CTL) + CW_BAR, MISC + 8);
#define IN(k) (lo <= (k) && (k) < hi)
#ifndef PROBE_DUP
#define PROBE_DUP 0
#endif
#define DUPN(k) (((PROBE_DUP >> (k)) & 1) ? 2 : 1)
#define SEAM(k) do { if (IN(k) && IN((k) + 1)) xcd_barrier(bar); } while (0)
    unsigned char* ws = args.ws;
    if (IN(0)) { for (int _r = 0; _r < DUPN(0); ++_r) { p0_prologue(F); if (DUPN(0) > 1) __syncthreads(); } } SEAM(0);
    if (IN(1)) { for (int _r = 0; _r < DUPN(1); ++_r) { p1_hnorm(F); if (DUPN(1) > 1) __syncthreads(); } } SEAM(1);
    if (IN(2)) { for (int _r = 0; _r < DUPN(2); ++_r) { SchedIn S{F.G, F.bid, (const char*)(ws + WS_H), (const char*)(ws + WS_WINT)}; EpiZ E{ws}; pg8::gemm_phase(F.lds + RING_OFF, 1024, S, E); p2_ctx_lora(F); if (DUPN(2) > 1) __syncthreads(); } } SEAM(2);
    if (IN(3)) { for (int _r = 0; _r < DUPN(3); ++_r) { p3_retstate(F); if (DUPN(3) > 1) __syncthreads(); } } SEAM(3);
    if (IN(4)) { for (int _r = 0; _r < DUPN(4); ++_r) { p4_retention(F); if (DUPN(4) > 1) __syncthreads(); } }
    if (IN(5)) { for (int _r = 0; _r < DUPN(5); ++_r) { p5_prep(F); if (DUPN(5) > 1) __syncthreads(); } } SEAM(5);
    if (IN(6)) { for (int _r = 0; _r < DUPN(6); ++_r) { p6_scan(F); if (DUPN(6) > 1) __syncthreads(); } } SEAM(6);
    if (IN(7)) { for (int _r = 0; _r < DUPN(7); ++_r) { p7_mergeprep(F); if (DUPN(7) > 1) __syncthreads(); } }
    if (IN(8)) { for (int _r = 0; _r < DUPN(8); ++_r) { SchedDense S{128, 4, F.G, F.bid, 512, (const char*)(ws + WS_ARET), (const char*)(ws + WS_WBRRET)}; EpiMix<false> E{(bf16*)F.out, (const bf16*)(ws + WS_Z6), 0}; pg8::gemm_phase(F.lds + RING_OFF, 512, S, E); if (DUPN(8) > 1) __syncthreads(); } } SEAM(8);
    if (IN(9)) { for (int _r = 0; _r < DUPN(9); ++_r) { SchedDense S{128, 4, F.G, F.bid, 512, (const char*)(ws + WS_ARW), (const char*)(ws + WS_WBRRW)}; EpiMix<true> E{(bf16*)F.out, (const bf16*)(ws + WS_Z6), 1024}; pg8::gemm_phase(F.lds + RING_OFF, 512, S, E); if (DUPN(9) > 1) __syncthreads(); } } SEAM(9);
    if (IN(10)) { for (int _r = 0; _r < DUPN(10); ++_r) { SchedDense S{128, 4, F.G, F.bid, 1024, (const char*)F.out, (const char*)(ws + WS_WOUT)}; EpiBf16 E{(bf16*)(ws + WS_YLAT), 1024}; pg8::gemm_phase(F.lds + RING_OFF, 1024, S, E); if (DUPN(10) > 1) __syncthreads(); } } SEAM(10);
    if (IN(11)) { for (int _r = 0; _r < DUPN(11); ++_r) { p11_rowpass(F); if (DUPN(11) > 1) __syncthreads(); } } SEAM(11);
    if (IN(12)) { for (int _r = 0; _r < DUPN(12); ++_r) { p12_topk(F); if (DUPN(12) > 1) __syncthreads(); } } SEAM(12);
    if (IN(14)) { for (int _r = 0; _r < DUPN(14); ++_r) { SchedUp S{F.G, F.bid, (const char*)(ws + WS_H2), (const char*)(ws + WS_WGU), (const int*)(ws + SM_IDX)}; EpiUp E{ws + WS_HID}; pg8::gemm_phase_f8<EpiUp, SchedUp, true>(F.lds + RING_OFF, 1024, S, E); if (DUPN(14) > 1) __syncthreads(); } } SEAM(14);
    if (IN(15)) { for (int _r = 0; _r < DUPN(15); ++_r) { SchedDown S{F.G, F.bid, (const char*)(ws + WS_HID), (const char*)(ws + WS_WDN)}; EpiDown E{(bf16*)(ws + WS_Y), (const float*)(ws + SM_GATE)}; pg8::gemm_phase_f8(F.lds + RING_OFF, 1024, S, E); if (DUPN(15) > 1) __syncthreads(); } } SEAM(15);
    if (IN(16)) { for (int _r = 0; _r < DUPN(16); ++_r) { p16_final(F); if (DUPN(16) > 1) __syncthreads(); } }
#undef IN
#undef SEAM
}

extern "C" void kernel_launch(void* const* d_in, const int* in_sizes, int n_in, void* d_out, int out_size, void* d_ws, size_t ws_size, hipStream_t stream) {
    static int grid = 0;
    if (grid == 0) {
        if (n_in != 28 || out_size != NTOK * D || ws_size < WS_END) { fprintf(stderr, "kernel_launch: unexpected sizes n_in %d out %d ws %zu\n", n_in, out_size, ws_size); grid = -1; return; }
        int dev = 0, cus = 0;
        if (hipGetDevice(&dev) != hipSuccess || hipDeviceGetAttribute(&cus, hipDeviceAttributeMultiprocessorCount, dev) != hipSuccess) { grid = -1; return; }
        if (hipFuncSetAttribute((const void*)mk_fwd, hipFuncAttributeMaxDynamicSharedMemorySize, LDS_BYTES) != hipSuccess) { fprintf(stderr, "kernel_launch: hipFuncSetAttribute failed\n"); grid = -1; return; }
        int per_cu = 0;
        if (hipOccupancyMaxActiveBlocksPerMultiprocessor(&per_cu, (const void*)mk_fwd, NTHR, LDS_BYTES) != hipSuccess || per_cu < 1) fprintf(stderr, "kernel_launch: occupancy query says %d\n", per_cu);
        (void)hipGetLastError();
        grid = cus;
    }
    if (grid < 0) return;
    (void)hipMemsetAsync((char*)d_ws + WS_CTL, 0, CTL_ZERO_BYTES, stream);
    Args a{};
    for (int i = 0; i < 28; ++i) a.in[i] = (const float*)d_in[i];
    a.out = (float*)d_out; a.ws = (unsigned char*)d_ws;
#if MK_N_LAUNCHES == 1
    a.ph_lo = 0; a.ph_hi = NPHASE; a.li = 0;
    hipLaunchKernelGGL(mk_fwd, dim3(grid), dim3(NTHR), LDS_BYTES, stream, a);
#else
    for (int p = 0; p < NPHASE; ++p) { a.ph_lo = p; a.ph_hi = p + 1; a.li = p; hipLaunchKernelGGL(mk_fwd, dim3(grid), dim3(NTHR), LDS_BYTES, stream, a); }
#endif
}
```
